# Optimizing an MI355X kernel written in HIP

```python
import jax, jax.numpy as jnp
from jax import lax
import numpy as np

D_MODEL = 1024
BATCH = 8
SEQ = 4096
DEPTH = 4

CHUNK = 64
N_PREV_CHUNKS = 8
BAND = N_PREV_CHUNKS + 1

D_MIX = D_MODEL
HEAD_DIM = 64
ATTN_WIDTH = D_MIX // 2
N_ATTN_HEADS = ATTN_WIDTH // HEAD_DIM
CONV_WIDTH = D_MIX // 4
CONV_K = 3
POOL_WIDTH = D_MIX - ATTN_WIDTH - CONV_WIDTH
POOL_WINDOWS = (2, 4, 8, 16)
N_POOL_GROUPS = len(POOL_WINDOWS)
POOL_GROUP = POOL_WIDTH // N_POOL_GROUPS
REL_CLIP = 128

D_IN = 3 * ATTN_WIDTH + 3 * CONV_WIDTH + POOL_WIDTH
D_FF = 4 * D_MODEL
EPS = 1e-6
NEG_INF = -1e30

kernel_name = "hybrid_chunked_attn_conv_pool_trunk"


def rms_norm(x, g):
    x32 = x.astype(jnp.float32)
    y = x32 * lax.rsqrt(jnp.mean(x32 * x32, axis=-1, keepdims=True) + EPS)
    return (y * g.astype(jnp.float32)).astype(x.dtype)


def chunked_band_attention(q, k, v, rel_bias):
    b, s, h, d = q.shape
    nc = s // CHUNK
    qc = q.reshape(b, nc, CHUNK, h, d)
    pad = ((0, 0), (N_PREV_CHUNKS, 0), (0, 0), (0, 0), (0, 0))
    kp = jnp.pad(k.reshape(b, nc, CHUNK, h, d), pad)
    vp = jnp.pad(v.reshape(b, nc, CHUNK, h, d), pad)
    band_idx = jnp.arange(nc)[:, None] + jnp.arange(BAND)[None, :]
    kb = kp[:, band_idx].reshape(b, nc, BAND * CHUNK, h, d)
    vb = vp[:, band_idx].reshape(b, nc, BAND * CHUNK, h, d)
    scores = jnp.einsum('bnqhd,bnkhd->bnhqk', qc, kb).astype(jnp.float32) * (d ** -0.5)
    qi = jnp.arange(CHUNK)[:, None]
    kj = jnp.arange(BAND * CHUNK)[None, :]
    dist = qi + N_PREV_CHUNKS * CHUNK - kj
    bias = rel_bias[:, jnp.clip(dist, -REL_CLIP, REL_CLIP) + REL_CLIP].astype(jnp.float32)
    valid = jnp.repeat(band_idx >= N_PREV_CHUNKS, CHUNK, axis=1)
    scores = jnp.where(valid[None, :, None, None, :], scores + bias[None, None], NEG_INF)
    p = jax.nn.softmax(scores, axis=-1).astype(v.dtype)
    out = jnp.einsum('bnhqk,bnkhd->bnqhd', p, vb)
    return out.reshape(b, s, h * d)


def gated_short_conv(gb, gc, hin, conv_w):
    z = gc * hin
    s = z.shape[1]
    zp = jnp.pad(z, ((0, 0), (CONV_K - 1, 0), (0, 0)))
    y = sum(conv_w[i] * zp[:, i:i + s] for i in range(CONV_K))
    return gb * y


def multiscale_pool(u, pool_w, pool_scale):
    b, s, c = u.shape
    u32 = u.astype(jnp.float32)
    cs = jnp.concatenate([jnp.zeros((b, 1, c), jnp.float32), jnp.cumsum(u32, axis=1)], axis=1)
    pos1 = jnp.arange(s) + 1
    outs = []
    for g, w in enumerate(POOL_WINDOWS):
        sl = slice(g * POOL_GROUP, (g + 1) * POOL_GROUP)
        csg = cs[:, :, sl]
        lag = jnp.pad(csg[:, :s + 1 - w], ((0, 0), (w - 1, 0), (0, 0)))
        cnt = jnp.minimum(pos1, w).astype(jnp.float32)[None, :, None]
        m = (csg[:, 1:] - lag) / cnt - u32[:, :, sl]
        outs.append(jnp.einsum('bsc,cd->bsd', m.astype(u.dtype), pool_w[g]))
    return jnp.concatenate(outs, axis=-1) * pool_scale


def setup_inputs(seed: int = 0) -> dict:
    key = jax.random.key(seed)
    ks = jax.random.split(key, 13)
    f32 = jnp.float32
    L = DEPTH
    x = jax.random.normal(ks[0], (BATCH, SEQ, D_MODEL), f32)
    norm1_g = 1.0 + 0.05 * jax.random.normal(ks[1], (L, D_MODEL), f32)
    w_in = jax.random.normal(ks[2], (L, D_MODEL, D_IN), f32) * D_MODEL ** -0.5
    q_norm_g = 1.0 + 0.05 * jax.random.normal(ks[3], (L, HEAD_DIM), f32)
    k_norm_g = 1.0 + 0.05 * jax.random.normal(ks[4], (L, HEAD_DIM), f32)
    rel_bias = 0.1 * jax.random.normal(ks[5], (L, N_ATTN_HEADS, 2 * REL_CLIP + 1), f32)
    conv_w = jax.random.normal(ks[6], (L, CONV_K, CONV_WIDTH), f32) * CONV_K ** -0.5
    pool_w = jax.random.normal(ks[7], (L, N_POOL_GROUPS, POOL_GROUP, POOL_GROUP), f32) * POOL_GROUP ** -0.5
    pool_scale = 0.5 + 0.1 * jax.random.normal(ks[8], (L, POOL_WIDTH), f32)
    w_out = jax.random.normal(ks[9], (L, D_MIX, D_MODEL), f32) * D_MIX ** -0.5
    norm2_g = 1.0 + 0.05 * jax.random.normal(ks[10], (L, D_MODEL), f32)
    w_mlp1 = jax.random.normal(ks[11], (L, D_MODEL, D_FF), f32) * D_MODEL ** -0.5
    w_mlp2 = jax.random.normal(ks[12], (L, D_FF, D_MODEL), f32) * D_FF ** -0.5
    return {"x": x, "norm1_g": norm1_g, "w_in": w_in, "q_norm_g": q_norm_g,
            "k_norm_g": k_norm_g, "rel_bias": rel_bias, "conv_w": conv_w,
            "pool_w": pool_w, "pool_scale": pool_scale, "w_out": w_out,
            "norm2_g": norm2_g, "w_mlp1": w_mlp1, "w_mlp2": w_mlp2}


def reference(x, norm1_g, w_in, q_norm_g, k_norm_g, rel_bias, conv_w, pool_w,
              pool_scale, w_out, norm2_g, w_mlp1, w_mlp2):
    b, s, _ = x.shape
    a = ATTN_WIDTH
    c = CONV_WIDTH
    for l in range(DEPTH):
        h = rms_norm(x, norm1_g[l])
        p = jnp.einsum('bsd,de->bse', h, w_in[l])
        q = p[..., 0:a].reshape(b, s, N_ATTN_HEADS, HEAD_DIM)
        k = p[..., a:2 * a].reshape(b, s, N_ATTN_HEADS, HEAD_DIM)
        v = p[..., 2 * a:3 * a].reshape(b, s, N_ATTN_HEADS, HEAD_DIM)
        o = 3 * a
        gb = p[..., o:o + c]
        gc = p[..., o + c:o + 2 * c]
        hin = p[..., o + 2 * c:o + 3 * c]
        u = p[..., o + 3 * c:]
        q = rms_norm(q, q_norm_g[l])
        k = rms_norm(k, k_norm_g[l])
        y_attn = chunked_band_attention(q, k, v, rel_bias[l])
        y_conv = gated_short_conv(gb, gc, hin, conv_w[l])
        y_pool = multiscale_pool(u, pool_w[l], pool_scale[l])
        mix = jnp.concatenate([y_attn, y_conv, y_pool], axis=-1)
        x = x + jnp.einsum('bse,ed->bsd', mix, w_out[l])
        h2 = rms_norm(x, norm2_g[l])
        f = jnp.square(jax.nn.relu(jnp.einsum('bsd,df->bsf', h2, w_mlp1[l])))
        x = x + jnp.einsum('bsf,fd->bsd', f, w_mlp2[l])
    return x
```

```cpp
#include <hip/hip_runtime.h>
#include <hip/hip_cooperative_groups.h>
#include <cstdio>
#include <cstdint>
namespace cg = cooperative_groups;

namespace pg8 {
#define PG8_LAS __attribute__((address_space(3)))
typedef unsigned short bf16_t;
typedef short bf16x8 __attribute__((ext_vector_type(8)));
typedef float f32x4 __attribute__((ext_vector_type(4)));
typedef unsigned u32x4 __attribute__((ext_vector_type(4)));
typedef unsigned u32x2 __attribute__((ext_vector_type(2)));
constexpr int BM = 256, BK = 64, HALF = 128, HTB = HALF * BK * 2  , STAGE_BYTES = 8 * HTB, NXCD = 8, WGM = 8;

__host__ __device__ __forceinline__ int lds_byte(int r, int c) { const int st = (r >> 4) * 2 + (c >> 5), rr = r & 15, cc = c & 31, ob = rr * 64 + cc * 2; return st * 1024 + (ob ^ (((ob >> 9) & 1) << 5)); }
__host__ __device__ __forceinline__ void stage_rc(int b, int& R, int& C) { const int st = b / 1024, sb = b % 1024, swz = sb ^ (((sb >> 9) & 1) << 5); R = (st >> 1) * 16 + swz / 64; C = (st & 1) * 32 + (swz % 64) / 2; }
__host__ __device__ __forceinline__ int perm32(int rho) { const int n = rho >> 4, i = rho & 15; return 8 * (i >> 2) + 4 * n + (i & 3); }

struct Unit { int pm, pn; };
struct Gemm { const bf16_t* A; const bf16_t* Bt; int M, N, K; };

struct StaticOrder {
    int nM, nN, nwg, G, c;
    __host__ __device__ void init(int M, int N, int G_, int c_) { nM = M / BM; nN = N / BM; nwg = nM * nN; G = G_; c = c_; }
    __host__ __device__ bool next(int i, Unit& u) const {
        const long L = (long)i * G + c; if (L >= nwg) return false;
        int wgid = (int)L; { const int q = nwg / NXCD, r = nwg % NXCD, xcd = wgid % NXCD, off = wgid / NXCD; wgid = (xcd < r ? xcd * (q + 1) : r * (q + 1) + (xcd - r) * q) + off; }
        const int nig = WGM * nN, gid = wgid / nig, fm = gid * WGM, gsz = (nM - fm) < WGM ? (nM - fm) : WGM;
        u.pm = fm + ((wgid % nig) % gsz); u.pn = (wgid % nig) / gsz; return true;
    }
    __device__ __forceinline__ void a_ready(const Unit&) const {}
    __device__ __forceinline__ void done(const Unit&) const {}
};

__device__ __forceinline__ int opaque_tid() { int t = threadIdx.x; asm volatile("" : "+v"(t)); return t; }
__device__ __forceinline__ unsigned cvt_pk_bf16(float lo, float hi) { unsigned r; asm volatile("v_cvt_pk_bf16_f32 %0, %1, %2" : "=v"(r) : "v"(lo), "v"(hi)); return r; }
__device__ __forceinline__ u32x4 pack8(const f32x4& v0, const f32x4& v1) { u32x4 w; w.x = cvt_pk_bf16(v0[0], v0[1]); w.y = cvt_pk_bf16(v0[2], v0[3]); w.z = cvt_pk_bf16(v1[0], v1[1]); w.w = cvt_pk_bf16(v1[2], v1[3]); return w; }
__device__ __forceinline__ float dot4(const f32x4& v) { return (v[0] * v[0] + v[1] * v[1]) + (v[2] * v[2] + v[3] * v[3]); }

constexpr float EPS = 1e-6f;
__device__ __forceinline__ float row_rstd(const float* ssp, int row) {
    const f32x4* p = (const f32x4*)(ssp + (size_t)row * 16); const f32x4 a = p[0], b = p[1], c = p[2], d = p[3];
    const float s = (((a[0] + a[1]) + (a[2] + a[3])) + ((b[0] + b[1]) + (b[2] + b[3]))) + (((c[0] + c[1]) + (c[2] + c[3])) + ((d[0] + d[1]) + (d[2] + d[3])));
    return rsqrtf(s * (1.f / 1024.f) + EPS);
}
constexpr float QSCALE = 0.125f * 1.4426950408889634f;

struct EpiIn {
    static constexpr bool PERM = true, AFTER_DRAIN = false;
    const float* ss; bf16_t* QB; bf16_t* KB; bf16_t* R; const float* qg; const float* kg;
    __device__ __forceinline__ void operator()(const f32x4 (&acc)[2][2][4][2], const Unit& u, int wr, int wc, int fr, int fq) const {
        const int row0 = u.pm * BM + wr * 64 + fr;
        if (u.pn < 4) {
            const bool isq = u.pn < 2;
            const float* gp = isq ? qg : kg;
            f32x4 gv[2][2];
#pragma unroll
            for (int bj = 0; bj < 2; ++bj)
#pragma unroll
                for (int n = 0; n < 2; ++n) gv[bj][n] = *(const f32x4*)(gp + 32 * bj + 8 * fq + 4 * n);
            const float post = isq ? QSCALE : 1.f;
#pragma unroll
            for (int ai = 0; ai < 2; ++ai)
#pragma unroll
                for (int m = 0; m < 4; ++m) {
                    const int row = row0 + ai * HALF + m * 16;
                    const float rs = row_rstd(ss, row);
                    f32x4 v[2][2]; float s = 0.f;
#pragma unroll
                    for (int bj = 0; bj < 2; ++bj)
#pragma unroll
                        for (int n = 0; n < 2; ++n) { v[bj][n] = acc[ai][bj][m][n] * rs; s += dot4(v[bj][n]); }
                    s += __shfl_xor(s, 16); s += __shfl_xor(s, 32);
                    const float hr = rsqrtf(s * (1.f / 64.f) + EPS) * post;
#pragma unroll
                    for (int bj = 0; bj < 2; ++bj) {
                        const f32x4 v0 = v[bj][0] * hr * gv[bj][0], v1 = v[bj][1] * hr * gv[bj][1];
                        const u32x4 w = pack8(v0, v1);
                        if (isq) { *(u32x4*)(QB + (size_t)row * 512 + (u.pn * 256 + 64 * wc + 32 * bj + 8 * fq)) = w; }
                        else {
                            const int h = (u.pn - 2) * 4 + wc, b = row >> 12, ch = (row >> 6) & 63, key = row & 63, dcol = 32 * bj + 8 * fq;
                            *(u32x4*)(KB + ((size_t)((b * 8 + h) * 64 + ch) * 4096 + (dcol >> 4) * 1024 + key * 16 + (dcol & 15))) = w;
                        }
                    }
                }
        } else {
#pragma unroll
            for (int ai = 0; ai < 2; ++ai)
#pragma unroll
                for (int m = 0; m < 4; ++m) {
                    const int row = row0 + ai * HALF + m * 16;
                    const float rs = row_rstd(ss, row);
#pragma unroll
                    for (int bj = 0; bj < 2; ++bj) {
                        const u32x4 w = pack8(acc[ai][bj][m][0] * rs, acc[ai][bj][m][1] * rs);
                        *(u32x4*)(R + (size_t)row * 1024 + ((u.pn - 4) * 256 + bj * HALF + wc * 32 + 8 * fq)) = w;
                    }
                }
        }
    }
};
struct EpiVT {
    static constexpr bool PERM = true, AFTER_DRAIN = false;
    const float* ss; bf16_t* VB;
    __device__ __forceinline__ void operator()(const f32x4 (&acc)[2][2][4][2], const Unit& u, int wr, int wc, int fr, int fq) const {
        const int f0 = u.pm * BM + wr * 64 + fr;
#pragma unroll
        for (int bj = 0; bj < 2; ++bj) {
            const int tok0 = u.pn * BM + bj * HALF + wc * 32 + 8 * fq;
            f32x4 r0, r1;
#pragma unroll
            for (int e = 0; e < 4; ++e) { r0[e] = row_rstd(ss, tok0 + e); r1[e] = row_rstd(ss, tok0 + 4 + e); }
            const int b = tok0 >> 12, ch = (tok0 >> 6) & 63, t = tok0 & 63;
#pragma unroll
            for (int ai = 0; ai < 2; ++ai)
#pragma unroll
                for (int m = 0; m < 4; ++m) {
                    const int f = f0 + ai * HALF + m * 16, h = f >> 6, d = f & 63;
                    const u32x4 w = pack8(acc[ai][bj][m][0] * r0, acc[ai][bj][m][1] * r1);
                    *(u32x4*)(VB + ((size_t)((b * 8 + h) * 64 + ch) * 4096 + (t >> 4) * 1024 + d * 16 + (t & 15))) = w;
                }
        }
    }
};
struct EpiRes {
    static constexpr bool PERM = true, AFTER_DRAIN = false;
    const float* base; float* out; bf16_t* XB; float* ssout;
    __device__ __forceinline__ void operator()(const f32x4 (&acc)[2][2][4][2], const Unit& u, int wr, int wc, int fr, int fq) const {
        const int row0 = u.pm * BM + wr * 64 + fr;
#pragma unroll
        for (int ai = 0; ai < 2; ++ai)
#pragma unroll
            for (int m = 0; m < 4; ++m) {
                const int row = row0 + ai * HALF + m * 16; float s = 0.f;
#pragma unroll
                for (int bj = 0; bj < 2; ++bj) {
                    const size_t off = (size_t)row * 1024 + (u.pn * BM + bj * HALF + wc * 32 + 8 * fq);
                    const f32x4 o0 = *(const f32x4*)(base + off) + acc[ai][bj][m][0], o1 = *(const f32x4*)(base + off + 4) + acc[ai][bj][m][1];
                    *(f32x4*)(out + off) = o0; *(f32x4*)(out + off + 4) = o1;
                    *(u32x4*)(XB + off) = pack8(o0, o1);
                    s += dot4(o0) + dot4(o1);
                }
                s += __shfl_xor(s, 16); s += __shfl_xor(s, 32);
                if (fq == 0) ssout[(size_t)row * 16 + u.pn * 4 + wc] = s;
            }
    }
};
struct EpiRelu2 {
    static constexpr bool PERM = true, AFTER_DRAIN = false;
    const float* ss; bf16_t* H;
    __device__ __forceinline__ void operator()(const f32x4 (&acc)[2][2][4][2], const Unit& u, int wr, int wc, int fr, int fq) const {
        const int row0 = u.pm * BM + wr * 64 + fr;
#pragma unroll
        for (int ai = 0; ai < 2; ++ai)
#pragma unroll
            for (int m = 0; m < 4; ++m) {
                const int row = row0 + ai * HALF + m * 16;
                const float rs = row_rstd(ss, row);
#pragma unroll
                for (int bj = 0; bj < 2; ++bj) {
                    f32x4 v0 = acc[ai][bj][m][0] * rs, v1 = acc[ai][bj][m][1] * rs;
#pragma unroll
                    for (int e = 0; e < 4; ++e) { const float a = fmaxf(v0[e], 0.f), c = fmaxf(v1[e], 0.f); v0[e] = a * a; v1[e] = c * c; }
                    *(u32x4*)(H + (size_t)row * 4096 + (u.pn * BM + bj * HALF + wc * 32 + 8 * fq)) = pack8(v0, v1);
                }
            }
    }
};

template <class Epi, class Sched, bool ALIGN_EPI = false, bool SP2 = false>
__device__ __forceinline__ void gemm_phase(PG8_LAS unsigned char* lds, const Gemm g, const Sched& S, const Epi& E) {
    const int tid = opaque_tid(), wid = __builtin_amdgcn_readfirstlane(tid >> 6), lane = tid & 63, wr = wid >> 2, wc = wid & 3, fr = lane & 15, fq = lane >> 4;
    const int K = g.K, nt = K / BK;
    unsigned voffA[2], voffB[2];
#pragma unroll
    for (int i = 0; i < 2; ++i) { int R, C; stage_rc(tid * 16 + i * 8192, R, C); const int Rb = Epi::PERM ? ((R & ~31) + perm32(R & 31)) : R;
        voffA[i] = (unsigned)(R * K + C) * 2u; voffB[i] = (unsigned)(Rb * K + C) * 2u; }
    const size_t kstep = (size_t)(BK * 2);
    const size_t hstep = (size_t)HALF * K * 2;
    const size_t tstep = 2 * hstep;
    const unsigned ldsw = (unsigned)wid * 1024u;
    const int aoff = lds_byte(wr * 64 + fr, fq * 8), boff = lds_byte(wc * 32 + fr, fq * 8);
#define PG8_SA(b, h) (((b) * 2 + (h)) * HTB)
#define PG8_SB(b, h) ((4 + (b) * 2 + (h)) * HTB)
#define PG8_STAGE(bufoff, gbase, voff) do { _Pragma("unroll") for (int _i = 0; _i < 2; ++_i) \
        __builtin_amdgcn_global_load_lds((const unsigned*)((const char*)(gbase) + (voff)[_i]), (PG8_LAS unsigned*)(lds + (bufoff) + ldsw + _i * 8192), 16, 0, 0); } while (0)
#define PG8_LDA(dst, b, h) do { _Pragma("unroll") for (int m = 0; m < 4; ++m) _Pragma("unroll") for (int k = 0; k < 2; ++k) dst[m][k] = *(const PG8_LAS bf16x8*)(lds + PG8_SA(b, h) + aoff + m * 2048 + k * 1024); } while (0)
#define PG8_LDB(dst, b, h) do { _Pragma("unroll") for (int n = 0; n < 2; ++n) _Pragma("unroll") for (int k = 0; k < 2; ++k) dst[n][k] = *(const PG8_LAS bf16x8*)(lds + PG8_SB(b, h) + boff + n * 2048 + k * 1024); } while (0)
#define PG8_MMA(ai, bj, At, Bt) do { __builtin_amdgcn_s_setprio(1); _Pragma("unroll") for (int m = 0; m < 4; ++m) _Pragma("unroll") for (int n = 0; n < 2; ++n) _Pragma("unroll") for (int k = 0; k < 2; ++k) \
        acc[ai][bj][m][n] = __builtin_amdgcn_mfma_f32_16x16x32_bf16(Bt[n][k], At[m][k], acc[ai][bj][m][n], 0, 0, 0); __builtin_amdgcn_s_setprio(0); } while (0)
#define PG8_WAIT_V(n) asm volatile("s_waitcnt vmcnt(" #n ")" ::: "memory")
#define PG8_WAIT_L(n) asm volatile("s_waitcnt lgkmcnt(" #n ")" ::: "memory")
#define PG8_BAR __builtin_amdgcn_s_barrier()
#define PG8_SCHED __builtin_amdgcn_sched_barrier(0)
    Unit cur, nxt; int ui = 0;
    if (!S.next(0, cur)) return;
    f32x4 acc[2][2][4][2];
#pragma unroll
    for (int a = 0; a < 2; ++a)
#pragma unroll
        for (int b = 0; b < 2; ++b)
#pragma unroll
            for (int m = 0; m < 4; ++m)
#pragma unroll
                for (int n = 0; n < 2; ++n) acc[a][b][m][n] = (f32x4){0.f, 0.f, 0.f, 0.f};
    bf16x8 At[4][2], B0[2][2], B1[2][2];
    const char* cA = (const char*)g.A + (size_t)cur.pm * tstep; const char* cB = (const char*)g.Bt + (size_t)cur.pn * tstep;
    S.a_ready(cur);
    if constexpr (SP2) {
        PG8_STAGE(PG8_SB(0, 0), cB, voffB); PG8_STAGE(PG8_SB(0, 1), cB + hstep, voffB); PG8_STAGE(PG8_SA(0, 0), cA, voffA); PG8_STAGE(PG8_SA(0, 1), cA + hstep, voffA);
        if (wr == 1) PG8_BAR;
        PG8_WAIT_V(2); PG8_BAR;
        PG8_STAGE(PG8_SB(1, 0), cB + kstep, voffB); PG8_STAGE(PG8_SA(1, 0), cA + kstep, voffA); PG8_STAGE(PG8_SB(1, 1), cB + hstep + kstep, voffB);
        PG8_WAIT_V(6); PG8_BAR;
    } else {
        PG8_STAGE(PG8_SB(0, 0), cB, voffB); PG8_STAGE(PG8_SA(0, 0), cA, voffA); PG8_STAGE(PG8_SB(0, 1), cB + hstep, voffB); PG8_STAGE(PG8_SA(0, 1), cA + hstep, voffA);
        if (wr == 1) PG8_BAR;
        PG8_WAIT_V(4); PG8_BAR;
        PG8_STAGE(PG8_SB(1, 0), cB + kstep, voffB); PG8_STAGE(PG8_SA(1, 0), cA + kstep, voffA); PG8_STAGE(PG8_SB(1, 1), cB + hstep + kstep, voffB);
        PG8_WAIT_V(6); PG8_BAR;
    }
    for (;;) {
        const bool has_next = S.next(ui + 1, nxt);
        const char* nA = has_next ? (const char*)g.A + (size_t)nxt.pm * tstep : cA; const char* nB = has_next ? (const char*)g.Bt + (size_t)nxt.pn * tstep : cB;
        for (int t = 0; t < nt; t += 2) {
            const bool last = (t == nt - 2);
            const char* a1 = cA + (size_t)(t + 1) * kstep;
            const char* a2 = last ? nA : cA + (size_t)(t + 2) * kstep; const char* b2 = last ? nB : cB + (size_t)(t + 2) * kstep;
            const char* a3 = a2 + kstep; const char* b3 = b2 + kstep;
            if (last && has_next) S.a_ready(nxt);
            if constexpr (SP2) {
            PG8_LDB(B0, 0, 0); PG8_LDB(B1, 0, 1); PG8_SCHED; PG8_LDA(At, 0, 0); PG8_STAGE(PG8_SA(1, 1), a1 + hstep, voffA);
            PG8_WAIT_V(8); PG8_WAIT_L(0); PG8_BAR; PG8_MMA(0, 0, At, B0); PG8_MMA(0, 1, At, B1); PG8_BAR; PG8_SCHED;
            PG8_LDA(At, 0, 1); PG8_STAGE(PG8_SB(0, 0), b2, voffB); PG8_STAGE(PG8_SB(0, 1), b2 + hstep, voffB); PG8_STAGE(PG8_SA(0, 0), a2, voffA);
            PG8_WAIT_V(8); PG8_WAIT_L(0); PG8_BAR; PG8_MMA(1, 0, At, B0); PG8_MMA(1, 1, At, B1); PG8_BAR; PG8_SCHED;
            PG8_LDB(B0, 1, 0); PG8_LDB(B1, 1, 1); PG8_SCHED; PG8_LDA(At, 1, 0); PG8_STAGE(PG8_SA(0, 1), a2 + hstep, voffA);
            PG8_WAIT_V(8); PG8_WAIT_L(0); PG8_BAR; PG8_MMA(0, 0, At, B0); PG8_MMA(0, 1, At, B1); PG8_BAR; PG8_SCHED;
            PG8_LDA(At, 1, 1); PG8_STAGE(PG8_SB(1, 0), b3, voffB); PG8_STAGE(PG8_SB(1, 1), b3 + hstep, voffB); PG8_STAGE(PG8_SA(1, 0), a3, voffA);
            PG8_WAIT_V(8); PG8_WAIT_L(0); PG8_BAR; PG8_MMA(1, 0, At, B0); PG8_MMA(1, 1, At, B1); PG8_BAR; PG8_SCHED;
            } else {
            PG8_LDB(B0, 0, 0); PG8_SCHED; PG8_LDA(At, 0, 0); PG8_STAGE(PG8_SA(1, 1), a1 + hstep, voffA);
            PG8_WAIT_L(8); PG8_BAR; PG8_WAIT_L(0); PG8_MMA(0, 0, At, B0); PG8_BAR; PG8_SCHED;
            PG8_LDB(B1, 0, 1); PG8_STAGE(PG8_SB(0, 0), b2, voffB);
            PG8_BAR; PG8_WAIT_L(0); PG8_MMA(0, 1, At, B1); PG8_BAR;
            PG8_LDA(At, 0, 1); PG8_STAGE(PG8_SA(0, 0), a2, voffA);
            PG8_BAR; PG8_WAIT_L(0); PG8_MMA(1, 0, At, B0); PG8_BAR; PG8_SCHED;
            PG8_STAGE(PG8_SB(0, 1), b2 + hstep, voffB);
            PG8_WAIT_V(6); PG8_BAR; PG8_MMA(1, 1, At, B1); PG8_BAR;
            PG8_LDB(B0, 1, 0); PG8_SCHED; PG8_LDA(At, 1, 0); PG8_STAGE(PG8_SA(0, 1), a2 + hstep, voffA);
            PG8_WAIT_L(8); PG8_BAR; PG8_WAIT_L(0); PG8_MMA(0, 0, At, B0); PG8_BAR; PG8_SCHED;
            PG8_LDB(B1, 1, 1); PG8_STAGE(PG8_SB(1, 0), b3, voffB);
            PG8_BAR; PG8_WAIT_L(0); PG8_MMA(0, 1, At, B1); PG8_BAR;
            PG8_LDA(At, 1, 1); PG8_STAGE(PG8_SA(1, 0), a3, voffA);
            PG8_BAR; PG8_WAIT_L(0); PG8_MMA(1, 0, At, B0); PG8_BAR; PG8_SCHED;
            PG8_STAGE(PG8_SB(1, 1), b3 + hstep, voffB);
            PG8_WAIT_V(6); PG8_BAR; PG8_MMA(1, 1, At, B1); PG8_BAR;
            }
        }
        if constexpr (ALIGN_EPI) { if (wr == 0) PG8_BAR; }
        if constexpr (!Epi::AFTER_DRAIN) { E(acc, cur, wr, wc, fr, fq); S.done(cur); }
        if (!has_next) break;
#pragma unroll
        for (int a = 0; a < 2; ++a)
#pragma unroll
            for (int b = 0; b < 2; ++b)
#pragma unroll
                for (int m = 0; m < 4; ++m)
#pragma unroll
                    for (int n = 0; n < 2; ++n) acc[a][b][m][n] = (f32x4){0.f, 0.f, 0.f, 0.f};
        cur = nxt; cA = nA; cB = nB; ++ui;
        if constexpr (ALIGN_EPI) { if (wr == 1) PG8_BAR; }
    }
    PG8_WAIT_V(0);
    if constexpr (!ALIGN_EPI) { if (wr == 0) PG8_BAR; }
    PG8_BAR;
#undef PG8_SA
#undef PG8_SB
#undef PG8_STAGE
#undef PG8_LDA
#undef PG8_LDB
#undef PG8_MMA
#undef PG8_WAIT_V
#undef PG8_WAIT_L
#undef PG8_BAR
#undef PG8_SCHED
}
}

constexpr int NWAVES = 8;
constexpr int DEPTH = 4, BATCH = 8, SEQ = 4096, D = 1024, M = BATCH * SEQ, DIN = 2560, FF = 4096, NH = 8;
constexpr int LDS_BYTES = 147456;
constexpr size_t MiB = 1u << 20;
constexpr size_t WS_SS = 416 * MiB, SS_BYTES = (size_t)9 * M * 16 * 4;
constexpr size_t WS_BAR = 1536 * 1024, BAR_BYTES = 16384;
constexpr int MISC_OFF = 131072 + 320;
constexpr size_t WS_W = 2 * MiB, W_LAYER = 23 * MiB;
constexpr size_t WO_MAIN = 0, WO_V = 4 * MiB, WO_OUT = 5 * MiB, WO_1 = 7 * MiB, WO_2 = 15 * MiB;
constexpr size_t WS_XB = 96 * MiB;
constexpr size_t WS_QB = 160 * MiB, WS_KB = 192 * MiB, WS_VB = 224 * MiB, WS_R = 256 * MiB, WS_MIX = 320 * MiB;
constexpr size_t WS_H = 160 * MiB;
constexpr size_t WS_END = 440 * MiB;
static_assert(WS_W + DEPTH * W_LAYER <= WS_XB && WS_SS + SS_BYTES <= WS_END, "ws map");

#define LAS __attribute__((address_space(3)))
typedef unsigned short bf16;
typedef unsigned v4u __attribute__((ext_vector_type(4)));
typedef unsigned v2u __attribute__((ext_vector_type(2)));
typedef float f32x4 __attribute__((ext_vector_type(4)));
typedef float f32x16 __attribute__((ext_vector_type(16)));
typedef short bf16x8 __attribute__((ext_vector_type(8)));
#define LDS_WAIT() asm volatile("s_waitcnt lgkmcnt(0)" ::: "memory")

__device__ __forceinline__ unsigned pk2(float lo, float hi) { return pg8::cvt_pk_bf16(lo, hi); }
__device__ __forceinline__ float bflo(unsigned w) { return __uint_as_float(w << 16); }
__device__ __forceinline__ float bfhi(unsigned w) { return __uint_as_float(w & 0xffff0000u); }
__device__ __forceinline__ float wave_sum(float v) {
#pragma unroll
    for (int o = 1; o < 64; o <<= 1) v += __shfl_xor(v, o);
    return v;
}

__device__ __forceinline__ void transpose_item(const float* W, int ldw, int k0, int ncol0, const float* gk, bf16* WT, int K, int drow0, LAS float* scr, int lane) {
#pragma unroll 8
    for (int i = 0; i < 32; ++i) { const int kk = 2 * i + (lane >> 5); float v = W[(size_t)(k0 + kk) * ldw + ncol0 + (lane & 31)]; if (gk) v *= gk[k0 + kk]; scr[kk * 33 + (lane & 31)] = v; }
    LDS_WAIT(); asm volatile("" ::: "memory");
    const int c = lane & 7;
#pragma unroll
    for (int j = 0; j < 4; ++j) { const int n = (lane >> 3) + 8 * j; const LAS float* s = scr + (8 * c) * 33 + n;
        v4u o; o.x = pk2(s[0 * 33], s[1 * 33]); o.y = pk2(s[2 * 33], s[3 * 33]); o.z = pk2(s[4 * 33], s[5 * 33]); o.w = pk2(s[6 * 33], s[7 * 33]);
        *(v4u*)(WT + (size_t)(drow0 + n) * K + k0 + 8 * c) = o; }
    LDS_WAIT(); asm volatile("" ::: "memory");
}

struct Args { const float* in[13]; float* out; unsigned char* ws; };

__device__ __forceinline__ void prologue(const Args& a, LAS unsigned char* lds) {
    const int tid = pg8::opaque_tid(), lane = tid & 63, wave = __builtin_amdgcn_readfirstlane(tid >> 6);
    LAS float* scr = (LAS float*)(lds + wave * 16384);
    const int gw = blockIdx.x * NWAVES + wave, NGW = gridDim.x * NWAVES;
    constexpr int PER_LAYER = 5760;
    for (int it = gw; it < DEPTH * PER_LAYER; it += NGW) {
        const int l = it / PER_LAYER; int r = it % PER_LAYER;
        unsigned char* wl = a.ws + WS_W + (size_t)l * W_LAYER;
        if (r < 1024) {
            const int kb = r >> 6, db = r & 63, pn = db >> 3, jb = db & 7, bj = jb >> 2, wc = jb & 3;
            const int scol = pn < 4 ? (256 * pn + 64 * wc + 32 * bj) : (1536 + 256 * (pn - 4) + 32 * jb);
            transpose_item(a.in[2] + (size_t)l * D * DIN, DIN, 64 * kb, scol, a.in[1] + l * D, (bf16*)(wl + WO_MAIN), D, 32 * db, scr, lane); continue; }
        r -= 1024;
        if (r < 256) { const int kb = r >> 4, db = r & 15;
            transpose_item(a.in[2] + (size_t)l * D * DIN, DIN, 64 * kb, 1024 + 32 * db, a.in[1] + l * D, (bf16*)(wl + WO_V), D, 32 * db, scr, lane); continue; }
        r -= 256;
        if (r < 384) { const int kb = r >> 5, nb = r & 31;
            transpose_item(a.in[9] + (size_t)l * D * D, D, 64 * kb, 32 * nb, nullptr, (bf16*)(wl + WO_OUT), D, 32 * nb, scr, lane); continue; }
        r -= 384;
        if (r < 2048) { const int kb = r >> 7, nb = r & 127;
            transpose_item(a.in[11] + (size_t)l * D * FF, FF, 64 * kb, 32 * nb, a.in[10] + l * D, (bf16*)(wl + WO_1), D, 32 * nb, scr, lane); continue; }
        r -= 2048;
        { const int kb = r >> 5, nb = r & 31;
            transpose_item(a.in[12] + (size_t)l * FF * D, D, 64 * kb, 32 * nb, nullptr, (bf16*)(wl + WO_2), FF, 32 * nb, scr, lane); }
    }
    for (int it = blockIdx.x * (NWAVES * 64) + tid; it < DEPTH * 4 * 8 * 1024; it += gridDim.x * NWAVES * 64) {
        const int n = it & 1023, cc = (it >> 10) & 7, g = (it >> 13) & 3, l = it >> 15;
        const float* wo = a.in[9] + (size_t)l * D * D + (size_t)(768 + 64 * g) * D + n;
        const float* sc = a.in[8] + l * 256 + 64 * g;
        const float* pw = a.in[7] + ((size_t)(l * 4 + g) * 64 + 8 * cc) * 64;
        float acc[8];
#pragma unroll
        for (int j = 0; j < 8; ++j) acc[j] = 0.f;
        for (int d = 0; d < 64; ++d) { const float wv = wo[(size_t)d * D] * sc[d];
#pragma unroll
            for (int j = 0; j < 8; ++j) acc[j] += pw[j * 64 + d] * wv; }
        v4u o; o.x = pk2(acc[0], acc[1]); o.y = pk2(acc[2], acc[3]); o.z = pk2(acc[4], acc[5]); o.w = pk2(acc[6], acc[7]);
        *(v4u*)((bf16*)(a.ws + WS_W + (size_t)l * W_LAYER + WO_OUT) + (size_t)n * D + 768 + 64 * g + 8 * cc) = o;
    }
    bf16* XB = (bf16*)(a.ws + WS_XB); float* ss0 = (float*)(a.ws + WS_SS);
    for (int m = gw; m < M; m += NGW) {
        const f32x4* xr = (const f32x4*)(a.in[0] + (size_t)m * D) + lane; float s = 0.f;
        unsigned long long* o8 = (unsigned long long*)(XB + (size_t)m * D) + lane;
#pragma unroll
        for (int j = 0; j < 4; ++j) { const f32x4 v = xr[64 * j]; s += pg8::dot4(v); o8[64 * j] = (unsigned long long)pk2(v[0], v[1]) | ((unsigned long long)pk2(v[2], v[3]) << 32); }
        s = wave_sum(s);
        if (lane < 16) ss0[(size_t)m * 16 + lane] = lane == 0 ? s : 0.f;
    }
}

__device__ __forceinline__ float max3f(float a, float b, float c) { return fmaxf(fmaxf(a, b), c); }
__device__ __forceinline__ float swap32_max(float m) { auto rr = __builtin_amdgcn_permlane32_swap(__float_as_uint(m), __float_as_uint(m), false, false); return fmaxf(__uint_as_float(rr[0]), __uint_as_float(rr[1])); }
__device__ __forceinline__ float swap32_sum(float m) { auto rr = __builtin_amdgcn_permlane32_swap(__float_as_uint(m), __float_as_uint(m), false, false); return __uint_as_float(rr[0]) + __uint_as_float(rr[1]); }
typedef float f32x2_t __attribute__((ext_vector_type(2))); typedef __bf16 bf16x2_t __attribute__((ext_vector_type(2)));
__device__ __forceinline__ unsigned cvtpk_s(float lo, float hi) { f32x2_t v = {lo, hi}; bf16x2_t b = __builtin_convertvector(v, bf16x2_t); return __builtin_bit_cast(unsigned, b); }

__device__ __forceinline__ void attn_wave_unit(int b, int h, int n, int half, const bf16* QB, const bf16* KB, const bf16* VB, bf16* MIX, const LAS float* tab, int lane) {
    const int r32 = lane & 31, hi = lane >> 5;
    const size_t tok = (size_t)b * SEQ + n * 64 + half * 32 + r32;
    bf16x8 qr[4];
#pragma unroll
    for (int d0 = 0; d0 < 4; ++d0) qr[d0] = *(const bf16x8*)(QB + tok * 512 + h * 64 + d0 * 16 + hi * 8);
    const int pk = (r32 & 19) | ((r32 & 4) << 1) | ((r32 & 8) >> 1);
    float mrun = -1e30f, l = 0.f; f32x16 o0 = f32x16{}, o1 = f32x16{};
    const LAS float* tb = tab + h * 260;
    const float cb = tb[256];
    const int qi = half * 32 + r32;
    for (int j = (n < 8 ? 8 - n : 0); j <= 8; ++j) {
        const int kc = n + j - 8;
        const size_t blk = (size_t)((b * NH + h) * 64 + kc) * 4096;
        const bf16* kb = KB + blk; const bf16* vb = VB + blk;
        bf16x8 kf[2][4], vf[2][4];
#pragma unroll
        for (int hf = 0; hf < 2; ++hf)
#pragma unroll
            for (int d0 = 0; d0 < 4; ++d0) kf[hf][d0] = *(const bf16x8*)(kb + d0 * 1024 + (pk + 32 * hf) * 16 + hi * 8);
#pragma unroll
        for (int dh = 0; dh < 2; ++dh)
#pragma unroll
            for (int s = 0; s < 4; ++s) vf[dh][s] = *(const bf16x8*)(vb + s * 1024 + (r32 + 32 * dh) * 16 + hi * 8);
        const float c0 = (j <= 5) ? cb : 0.f;
        f32x16 p0, p1;
#pragma unroll
        for (int r = 0; r < 16; ++r) { p0[r] = c0; p1[r] = c0; }
#pragma unroll
        for (int d0 = 0; d0 < 4; ++d0) { p0 = __builtin_amdgcn_mfma_f32_32x32x16_bf16(kf[0][d0], qr[d0], p0, 0, 0, 0); p1 = __builtin_amdgcn_mfma_f32_32x32x16_bf16(kf[1][d0], qr[d0], p1, 0, 0, 0); }
        if (j >= 6) {
            const int base = qi + 64 * (8 - j) + 128 - 8 * hi;
#pragma unroll
            for (int r = 0; r < 16; ++r) { const int key = (r >> 3) * 16 + (r & 7); int i0 = base - key, i1 = base - key - 32; i0 = i0 > 256 ? 256 : i0; i1 = i1 > 256 ? 256 : i1; p0[r] += tb[i0]; p1[r] += tb[i1]; }
        }
        float rm = max3f(p0[0], p0[1], p1[0]);
#pragma unroll
        for (int r = 1; r < 16; ++r) rm = max3f(rm, p0[r], p1[r]);
        rm = fmaxf(rm, p0[0]); rm = swap32_max(rm);
        const float mnew = fmaxf(mrun, rm), alpha = __builtin_amdgcn_exp2f(mrun - mnew); mrun = mnew;
        float rsum = 0.f;
#pragma unroll
        for (int r = 0; r < 16; ++r) { p0[r] = __builtin_amdgcn_exp2f(p0[r] - mnew); p1[r] = __builtin_amdgcn_exp2f(p1[r] - mnew); rsum += p0[r] + p1[r]; }
        l = l * alpha + rsum;
#pragma unroll
        for (int r = 0; r < 16; ++r) { o0[r] *= alpha; o1[r] *= alpha; }
        v4u pw[4];
#pragma unroll
        for (int s = 0; s < 2; ++s) {
            pw[s] = (v4u){cvtpk_s(p0[8 * s + 0], p0[8 * s + 1]), cvtpk_s(p0[8 * s + 2], p0[8 * s + 3]), cvtpk_s(p0[8 * s + 4], p0[8 * s + 5]), cvtpk_s(p0[8 * s + 6], p0[8 * s + 7])};
            pw[2 + s] = (v4u){cvtpk_s(p1[8 * s + 0], p1[8 * s + 1]), cvtpk_s(p1[8 * s + 2], p1[8 * s + 3]), cvtpk_s(p1[8 * s + 4], p1[8 * s + 5]), cvtpk_s(p1[8 * s + 6], p1[8 * s + 7])};
        }
#pragma unroll
        for (int s = 0; s < 4; ++s) { const bf16x8 pf = __builtin_bit_cast(bf16x8, pw[s]);
            o0 = __builtin_amdgcn_mfma_f32_32x32x16_bf16(vf[0][s], pf, o0, 0, 0, 0); o1 = __builtin_amdgcn_mfma_f32_32x32x16_bf16(vf[1][s], pf, o1, 0, 0, 0); }
    }
    const float linv = 1.f / swap32_sum(l);
    bf16* orow = MIX + tok * 1024 + h * 64 + 4 * hi;
#pragma unroll
    for (int r4 = 0; r4 < 4; ++r4) {
        v2u w0, w1;
        w0.x = cvtpk_s(o0[4 * r4] * linv, o0[4 * r4 + 1] * linv); w0.y = cvtpk_s(o0[4 * r4 + 2] * linv, o0[4 * r4 + 3] * linv);
        w1.x = cvtpk_s(o1[4 * r4] * linv, o1[4 * r4 + 1] * linv); w1.y = cvtpk_s(o1[4 * r4 + 2] * linv, o1[4 * r4 + 3] * linv);
        *(v2u*)(orow + 8 * r4) = w0; *(v2u*)(orow + 32 + 8 * r4) = w1;
    }
}

__device__ __forceinline__ void unpack8(const v4u w, float (&f)[8]) { f[0] = bflo(w.x); f[1] = bfhi(w.x); f[2] = bflo(w.y); f[3] = bfhi(w.y); f[4] = bflo(w.z); f[5] = bfhi(w.z); f[6] = bflo(w.w); f[7] = bfhi(w.w); }

__device__ __forceinline__ void mixer_phase(const Args& a, int l, LAS unsigned char* lds) {
    const int tid = pg8::opaque_tid(), lane = tid & 63, wave = __builtin_amdgcn_readfirstlane(tid >> 6);
    const bf16* QB = (const bf16*)(a.ws + WS_QB); const bf16* KB = (const bf16*)(a.ws + WS_KB); const bf16* VB = (const bf16*)(a.ws + WS_VB);
    const bf16* R = (const bf16*)(a.ws + WS_R); bf16* MIX = (bf16*)(a.ws + WS_MIX);
    LAS float* tab = (LAS float*)lds;
    { const float* rb = a.in[5] + (size_t)l * NH * 257;
      for (int i = tid; i < NH * 257; i += NWAVES * 64) { const int h = i / 257, e = i % 257; tab[h * 260 + e] = rb[i] * 1.4426950408889634f; } }
    __syncthreads();
    const int gw = blockIdx.x * NWAVES + wave, NGW = gridDim.x * NWAVES;
    for (int u = gw; u < BATCH * NH * 64 * 2; u += NGW) {
        const int half = u & 1, h = (u >> 1) & 7, n = (u >> 4) & 63, b = u >> 10;
        attn_wave_unit(b, h, n, half, QB, KB, VB, MIX, tab, lane);
    }
    const int gt = blockIdx.x * (NWAVES * 64) + tid, NGT = gridDim.x * NWAVES * 64;
    for (int it = gt; it < 131072; it += NGT) {
        const int type = it >> 16, vec = it & 31, run = (it & 65535) >> 5;
        const size_t tok0 = (size_t)run * 16; const int tpos0 = (int)(tok0 & (SEQ - 1)); const int c = vec * 8;
        if (type == 0) {
            const float* cw = a.in[6] + (size_t)l * 3 * 256 + c;
            float w0[8], w1[8], w2[8], zp2[8], zp1[8];
            { const f32x4 x0 = *(const f32x4*)(cw), x1 = *(const f32x4*)(cw + 4), y0 = *(const f32x4*)(cw + 256), y1 = *(const f32x4*)(cw + 260), z0 = *(const f32x4*)(cw + 512), z1 = *(const f32x4*)(cw + 516);
#pragma unroll
              for (int e = 0; e < 4; ++e) { w0[e] = x0[e]; w0[4 + e] = x1[e]; w1[e] = y0[e]; w1[4 + e] = y1[e]; w2[e] = z0[e]; w2[4 + e] = z1[e]; } }
            if (tpos0 >= 2) {
                float g1[8], h1[8], g2[8], h2[8];
                unpack8(*(const v4u*)(R + (tok0 - 2) * 1024 + 256 + c), g2); unpack8(*(const v4u*)(R + (tok0 - 2) * 1024 + 512 + c), h2);
                unpack8(*(const v4u*)(R + (tok0 - 1) * 1024 + 256 + c), g1); unpack8(*(const v4u*)(R + (tok0 - 1) * 1024 + 512 + c), h1);
#pragma unroll
                for (int e = 0; e < 8; ++e) { zp2[e] = g2[e] * h2[e]; zp1[e] = g1[e] * h1[e]; }
            } else {
#pragma unroll
                for (int e = 0; e < 8; ++e) { zp2[e] = 0.f; zp1[e] = 0.f; }
            }
            for (int t = 0; t < 16; ++t) {
                const bf16* rr = R + (tok0 + t) * 1024 + c;
                float gb[8], gc[8], hn[8], y[8];
                unpack8(*(const v4u*)(rr), gb); unpack8(*(const v4u*)(rr + 256), gc); unpack8(*(const v4u*)(rr + 512), hn);
#pragma unroll
                for (int e = 0; e < 8; ++e) { const float z = gc[e] * hn[e]; y[e] = gb[e] * (w0[e] * zp2[e] + w1[e] * zp1[e] + w2[e] * z); zp2[e] = zp1[e]; zp1[e] = z; }
                v4u o; o.x = pk2(y[0], y[1]); o.y = pk2(y[2], y[3]); o.z = pk2(y[4], y[5]); o.w = pk2(y[6], y[7]);
                *(v4u*)(MIX + (tok0 + t) * 1024 + 512 + c) = o;
            }
        } else {
            const int w = 2 << (vec >> 3);
            const bf16* ub = R + 768 + c;
            float S[8];
#pragma unroll
            for (int e = 0; e < 8; ++e) S[e] = 0.f;
            if (tpos0 > 0) {
                for (int j = 1; j < w; ++j) { float uu[8]; unpack8(*(const v4u*)(ub + (tok0 - j) * 1024), uu);
#pragma unroll
                    for (int e = 0; e < 8; ++e) S[e] += uu[e]; }
            }
            for (int t = 0; t < 16; ++t) {
                float ut[8], mm[8]; unpack8(*(const v4u*)(ub + (tok0 + t) * 1024), ut);
                const int tp = tpos0 + t; const float cnt = (float)(tp + 1 < w ? tp + 1 : w);
#pragma unroll
                for (int e = 0; e < 8; ++e) { S[e] += ut[e]; mm[e] = S[e] / cnt - ut[e]; }
                v4u o; o.x = pk2(mm[0], mm[1]); o.y = pk2(mm[2], mm[3]); o.z = pk2(mm[4], mm[5]); o.w = pk2(mm[6], mm[7]);
                *(v4u*)(MIX + (tok0 + t) * 1024 + 768 + c) = o;
                if (tp - (w - 1) >= 0) { float uo[8]; unpack8(*(const v4u*)(ub + (tok0 + t - (w - 1)) * 1024), uo);
#pragma unroll
                    for (int e = 0; e < 8; ++e) S[e] -= uo[e]; }
            }
        }
    }
    __syncthreads();
}

#define XB_TMO      128
#define XB_XCNT(j)  (256  + 64 * (j))
#define XB_XSUB(j)  (1280 + 64 * (j))
#define XB_XGEN(j)  (2304 + 64 * (j))
#define XB_TOP      3328
#define XB_TOPGEN   3392
#define XCD_BAR_WORDS 3456
#define XB_SPIN_CAP (1u << 22)
__device__ __forceinline__ unsigned xb_ld(unsigned* p)              { return __hip_atomic_load(p, __ATOMIC_RELAXED, __HIP_MEMORY_SCOPE_AGENT); }
__device__ __forceinline__ unsigned xb_add(unsigned* p, unsigned v) { return __hip_atomic_fetch_add(p, v, __ATOMIC_RELAXED, __HIP_MEMORY_SCOPE_AGENT); }
__device__ __forceinline__ unsigned xb_xcc_id() { return (unsigned)__builtin_amdgcn_s_getreg((3 << 11) | 20) & 0xFu; }
#define XB_SPIN(cond, bar) do { unsigned _sp = 0; while (cond) { __builtin_amdgcn_s_sleep(1); \
    if ((++_sp & 255u) == 0u) { if (xb_ld(&(bar)[XB_TMO])) break; if (_sp > XB_SPIN_CAP) { atomicAdd(&(bar)[XB_TMO], 1u); break; } } } } while (0)
struct XcdBarrier { unsigned* bar; unsigned x; volatile LAS unsigned* st; };
__device__ __forceinline__ XcdBarrier xcd_barrier_post(unsigned* bar, volatile LAS unsigned* st) {
    XcdBarrier b; b.bar = bar; b.x = xb_xcc_id(); b.st = st;
    if (threadIdx.x == 0) (void)xb_add(&bar[XB_XCNT(b.x)], 1u);
    return b;
}
__device__ __forceinline__ void xcd_barrier_complete(unsigned* bar, unsigned x, unsigned& nloc, unsigned& nx) {
    const unsigned G = gridDim.x * gridDim.y * gridDim.z;
    unsigned sum, cnt, mine, sp = 0u;
    for (;;) {
        sum = 0u; cnt = 0u; mine = 0u;
#pragma unroll
        for (unsigned j = 0; j < 16; ++j) { const unsigned c = xb_ld(&bar[XB_XCNT(j)]); sum += c; cnt += (c > 0u) ? 1u : 0u; mine = (j == x) ? c : mine; }
        if (sum == G) break;
        __builtin_amdgcn_s_sleep(1);
        if ((++sp & 255u) == 0u) { if (xb_ld(&bar[XB_TMO])) break; if (sp > XB_SPIN_CAP) { atomicAdd(&bar[XB_TMO], 1u); break; } }
    }
    nloc = mine > 0u ? mine : 1u; nx = cnt > 0u ? cnt : 1u;
}
__device__ __forceinline__ void xcd_barrier(const XcdBarrier& b) {
    asm volatile("s_waitcnt vmcnt(0)" ::: "memory");
    __syncthreads();
    if (threadIdx.x == 0) {
        unsigned* bar = b.bar;
        __builtin_amdgcn_s_waitcnt(0);
        unsigned nloc = b.st[0], nx = b.st[1];
        if (nloc == 0u) { xcd_barrier_complete(bar, b.x, nloc, nx); b.st[0] = nloc; b.st[1] = nx; }
        const unsigned old = xb_add(&bar[XB_XSUB(b.x)], 1u);
        const unsigned gen = old / nloc;
        if (old + 1u == (gen + 1u) * nloc) {
            __builtin_amdgcn_fence(__ATOMIC_RELEASE, "agent");
            asm volatile("s_waitcnt vmcnt(0)" ::: "memory");
            const unsigned og = xb_add(&bar[XB_TOP], 1u);
            const unsigned tg = og / nx;
            if (og + 1u == (tg + 1u) * nx) xb_add(&bar[XB_TOPGEN], 1u);
            else XB_SPIN(xb_ld(&bar[XB_TOPGEN]) == tg, bar);
            __builtin_amdgcn_fence(__ATOMIC_ACQUIRE, "agent");
            xb_add(&bar[XB_XGEN(b.x)], 1u);
            asm volatile("s_waitcnt vmcnt(0)" ::: "memory");
        } else {
            XB_SPIN(xb_ld(&bar[XB_XGEN(b.x)]) == gen, bar);
            __builtin_amdgcn_fence(__ATOMIC_ACQUIRE, "agent");
            asm volatile("s_waitcnt vmcnt(0)" ::: "memory");
        }
    }
    __syncthreads();
}
#define gsync(grid) do { XcdBarrier b_; b_.bar = (unsigned*)(a.ws + WS_BAR); b_.x = xb_xcc_id(); b_.st = (volatile LAS unsigned*)(lds + MISC_OFF) + 8; xcd_barrier(b_); } while (0)
__global__ void __launch_bounds__(NWAVES * 64, 2) fwd_megakernel(Args a) {
    extern __shared__ __attribute__((aligned(16))) unsigned char lds_raw[];
    LAS unsigned char* lds = (LAS unsigned char*)lds_raw;
    cg::grid_group grid = cg::this_grid();
    const int G = gridDim.x;
    unsigned char* ws = a.ws;
    float* ss = (float*)(ws + WS_SS);
    bf16* XB = (bf16*)(ws + WS_XB); bf16* QB = (bf16*)(ws + WS_QB); bf16* KB = (bf16*)(ws + WS_KB); bf16* VB = (bf16*)(ws + WS_VB);
    bf16* R = (bf16*)(ws + WS_R); bf16* MIX = (bf16*)(ws + WS_MIX); bf16* HB = (bf16*)(ws + WS_H);

    volatile LAS unsigned* MISC = (volatile LAS unsigned*)(lds + MISC_OFF);
    if (threadIdx.x < 32) MISC[threadIdx.x] = 0u;
    __syncthreads();
    (void)xcd_barrier_post((unsigned*)(ws + WS_BAR), MISC + 8);
    grid.sync();
    prologue(a, lds);
    gsync(grid);

    for (int l = 0; l < DEPTH; ++l) {
        unsigned char* wl = ws + WS_W + (size_t)l * W_LAYER;
        const float* ss1 = ss + (size_t)(2 * l) * M * 16; float* ss2 = ss + (size_t)(2 * l + 1) * M * 16; float* ss3 = ss + (size_t)(2 * l + 2) * M * 16;
        {
            pg8::Gemm g{XB, (const bf16*)(wl + WO_MAIN), M, 2048, D}; pg8::StaticOrder S; S.init(M, 2048, G, (int)blockIdx.x);
            pg8::EpiIn E{ss1, QB, KB, R, a.in[3] + l * 64, a.in[4] + l * 64};
            pg8::gemm_phase<pg8::EpiIn, pg8::StaticOrder, true, true>(lds, g, S, E);
            pg8::Gemm g2{(const bf16*)(wl + WO_V), XB, 512, M, D}; pg8::StaticOrder S2; S2.init(512, M, G, (int)blockIdx.x);
            pg8::EpiVT E2{ss1, VB};
            pg8::gemm_phase<pg8::EpiVT, pg8::StaticOrder, true, true>(lds, g2, S2, E2);
        }
        gsync(grid);
        mixer_phase(a, l, lds);
        gsync(grid);
        {
            pg8::Gemm g{MIX, (const bf16*)(wl + WO_OUT), M, D, D}; pg8::StaticOrder S; S.init(M, D, G, (int)blockIdx.x);
            pg8::EpiRes E{l == 0 ? a.in[0] : a.out, a.out, XB, ss2};
            pg8::gemm_phase<pg8::EpiRes, pg8::StaticOrder, true, true>(lds, g, S, E);
        }
        gsync(grid);
        {
            pg8::Gemm g{XB, (const bf16*)(wl + WO_1), M, FF, D}; pg8::StaticOrder S; S.init(M, FF, G, (int)blockIdx.x);
            pg8::EpiRelu2 E{ss2, HB};
            pg8::gemm_phase<pg8::EpiRelu2, pg8::StaticOrder, true, true>(lds, g, S, E);
        }
        gsync(grid);
        {
            pg8::Gemm g{HB, (const bf16*)(wl + WO_2), M, D, FF}; pg8::StaticOrder S; S.init(M, D, G, (int)blockIdx.x);
            pg8::EpiRes E{a.out, a.out, XB, ss3};
            pg8::gemm_phase<pg8::EpiRes, pg8::StaticOrder, true, true>(lds, g, S, E);
        }
        if (l + 1 < DEPTH) gsync(grid);
    }
}

extern "C" void kernel_launch(void* const* d_in, const int* in_sizes, int n_in, void* d_out, int out_size, void* d_ws, size_t ws_size, hipStream_t stream) {
    static int grid = 0;
    if (grid == 0) {
        if (n_in != 13 || in_sizes[0] != M * D || out_size != M * D || ws_size < WS_END) { fprintf(stderr, "kernel_launch: unexpected shapes (n_in %d, in0 %d, out %d, ws %zu)\n", n_in, n_in > 0 ? in_sizes[0] : -1, out_size, ws_size); grid = -1; return; }
        int dev = 0, cus = 0, per_cu = 0;
        (void)hipGetDevice(&dev); (void)hipDeviceGetAttribute(&cus, hipDeviceAttributeMultiprocessorCount, dev);
        if (hipFuncSetAttribute((const void*)fwd_megakernel, hipFuncAttributeMaxDynamicSharedMemorySize, LDS_BYTES) != hipSuccess) { fprintf(stderr, "kernel_launch: hipFuncSetAttribute failed\n"); grid = -1; return; }
        if (hipOccupancyMaxActiveBlocksPerMultiprocessor(&per_cu, (const void*)fwd_megakernel, NWAVES * 64, LDS_BYTES) != hipSuccess || per_cu < 1) { fprintf(stderr, "kernel_launch: occupancy query says %d\n", per_cu); per_cu = 1; }
        (void)hipGetLastError();
        grid = cus;
    }
    if (grid < 0) return;
    (void)hipMemsetAsync((char*)d_ws + WS_BAR, 0, BAR_BYTES, stream);
    Args a{};
    for (int i = 0; i < 13; ++i) a.in[i] = (const float*)d_in[i];
    a.out = (float*)d_out; a.ws = (unsigned char*)d_ws;
    void* args[] = {&a};
    hipError_t e = hipLaunchCooperativeKernel((const void*)fwd_megakernel, dim3(grid), dim3(NWAVES * 64), args, LDS_BYTES, stream);
    if (e != hipSuccess) fprintf(stderr, "cooperative launch failed: %s (grid %d)\n", hipGetErrorString(e), grid);
}
```

```cpp
#include <hip/hip_runtime.h>
#include <hip/hip_cooperative_groups.h>
#include <cstdio>
#include <cstdint>
namespace cg = cooperative_groups;

namespace pg8 {
#define PG8_LAS __attribute__((address_space(3)))
typedef unsigned short bf16_t;
typedef short bf16x8 __attribute__((ext_vector_type(8)));
typedef float f32x4 __attribute__((ext_vector_type(4)));
typedef unsigned u32x4 __attribute__((ext_vector_type(4)));
typedef unsigned u32x2 __attribute__((ext_vector_type(2)));
constexpr int BM = 256, BK = 64, HALF = 128, HTB = HALF * BK * 2  , STAGE_BYTES = 8 * HTB, NXCD = 8, WGM = 8;

__host__ __device__ __forceinline__ int lds_byte(int r, int c) { const int st = (r >> 4) * 2 + (c >> 5), rr = r & 15, cc = c & 31, ob = rr * 64 + cc * 2; return st * 1024 + (ob ^ (((ob >> 9) & 1) << 5)); }
__host__ __device__ __forceinline__ void stage_rc(int b, int& R, int& C) { const int st = b / 1024, sb = b % 1024, swz = sb ^ (((sb >> 9) & 1) << 5); R = (st >> 1) * 16 + swz / 64; C = (st & 1) * 32 + (swz % 64) / 2; }
__host__ __device__ __forceinline__ int perm32(int rho) { const int n = rho >> 4, i = rho & 15; return 8 * (i >> 2) + 4 * n + (i & 3); }

struct Unit { int pm, pn; };
struct Gemm { const bf16_t* A; const bf16_t* Bt; int M, N, K; };

struct StaticOrder {
    int nM, nN, nwg, G, c;
    __host__ __device__ void init(int M, int N, int G_, int c_) { nM = M / BM; nN = N / BM; nwg = nM * nN; G = G_; c = c_; }
    __host__ __device__ bool next(int i, Unit& u) const {
        const long L = (long)i * G + c; if (L >= nwg) return false;
        int wgid = (int)L; { const int q = nwg / NXCD, r = nwg % NXCD, xcd = wgid % NXCD, off = wgid / NXCD; wgid = (xcd < r ? xcd * (q + 1) : r * (q + 1) + (xcd - r) * q) + off; }
        const int nig = WGM * nN, gid = wgid / nig, fm = gid * WGM, gsz = (nM - fm) < WGM ? (nM - fm) : WGM;
        u.pm = fm + ((wgid % nig) % gsz); u.pn = (wgid % nig) / gsz; return true;
    }
    __device__ __forceinline__ void a_ready(const Unit&) const {}
    __device__ __forceinline__ void done(const Unit&) const {}
};

__device__ __forceinline__ int opaque_tid() { int t = threadIdx.x; asm volatile("" : "+v"(t)); return t; }
__device__ __forceinline__ unsigned cvt_pk_bf16(float lo, float hi) { unsigned r; asm volatile("v_cvt_pk_bf16_f32 %0, %1, %2" : "=v"(r) : "v"(lo), "v"(hi)); return r; }
__device__ __forceinline__ u32x4 pack8(const f32x4& v0, const f32x4& v1) { u32x4 w; w.x = cvt_pk_bf16(v0[0], v0[1]); w.y = cvt_pk_bf16(v0[2], v0[3]); w.z = cvt_pk_bf16(v1[0], v1[1]); w.w = cvt_pk_bf16(v1[2], v1[3]); return w; }
__device__ __forceinline__ float dot4(const f32x4& v) { return (v[0] * v[0] + v[1] * v[1]) + (v[2] * v[2] + v[3] * v[3]); }

constexpr float EPS = 1e-6f;
__device__ __forceinline__ float row_rstd(const float* ssp, int row) {
    const f32x4* p = (const f32x4*)(ssp + (size_t)row * 16); const f32x4 a = p[0], b = p[1], c = p[2], d = p[3];
    const float s = (((a[0] + a[1]) + (a[2] + a[3])) + ((b[0] + b[1]) + (b[2] + b[3]))) + (((c[0] + c[1]) + (c[2] + c[3])) + ((d[0] + d[1]) + (d[2] + d[3])));
    return rsqrtf(s * (1.f / 1024.f) + EPS);
}
constexpr float QSCALE = 0.125f * 1.4426950408889634f;

struct EpiIn {
    static constexpr bool PERM = true, AFTER_DRAIN = false;
    const float* ss; bf16_t* QB; bf16_t* KB; bf16_t* R; const float* qg; const float* kg;
    __device__ __forceinline__ void operator()(const f32x4 (&acc)[2][2][4][2], const Unit& u, int wr, int wc, int fr, int fq) const {
        const int row0 = u.pm * BM + wr * 64 + fr;
        if (u.pn < 4) {
            const bool isq = u.pn < 2;
            const float* gp = isq ? qg : kg;
            f32x4 gv[2][2];
#pragma unroll
            for (int bj = 0; bj < 2; ++bj)
#pragma unroll
                for (int n = 0; n < 2; ++n) gv[bj][n] = *(const f32x4*)(gp + 32 * bj + 8 * fq + 4 * n);
            const float post = isq ? QSCALE : 1.f;
#pragma unroll
            for (int ai = 0; ai < 2; ++ai)
#pragma unroll
                for (int m = 0; m < 4; ++m) {
                    const int row = row0 + ai * HALF + m * 16;
                    const float rs = row_rstd(ss, row);
                    f32x4 v[2][2]; float s = 0.f;
#pragma unroll
                    for (int bj = 0; bj < 2; ++bj)
#pragma unroll
                        for (int n = 0; n < 2; ++n) { v[bj][n] = acc[ai][bj][m][n] * rs; s += dot4(v[bj][n]); }
                    s += __shfl_xor(s, 16); s += __shfl_xor(s, 32);
                    const float hr = rsqrtf(s * (1.f / 64.f) + EPS) * post;
#pragma unroll
                    for (int bj = 0; bj < 2; ++bj) {
                        const f32x4 v0 = v[bj][0] * hr * gv[bj][0], v1 = v[bj][1] * hr * gv[bj][1];
                        const u32x4 w = pack8(v0, v1);
                        if (isq) { *(u32x4*)(QB + (size_t)row * 512 + (u.pn * 256 + 64 * wc + 32 * bj + 8 * fq)) = w; }
                        else {
                            const int h = (u.pn - 2) * 4 + wc, b = row >> 12, ch = (row >> 6) & 63, key = row & 63, dcol = 32 * bj + 8 * fq;
                            *(u32x4*)(KB + ((size_t)((b * 8 + h) * 64 + ch) * 4096 + (dcol >> 4) * 1024 + key * 16 + (dcol & 15))) = w;
                        }
                    }
                }
        } else {
#pragma unroll
            for (int ai = 0; ai < 2; ++ai)
#pragma unroll
                for (int m = 0; m < 4; ++m) {
                    const int row = row0 + ai * HALF + m * 16;
                    const float rs = row_rstd(ss, row);
#pragma unroll
                    for (int bj = 0; bj < 2; ++bj) {
                        const u32x4 w = pack8(acc[ai][bj][m][0] * rs, acc[ai][bj][m][1] * rs);
                        *(u32x4*)(R + (size_t)row * 1024 + ((u.pn - 4) * 256 + bj * HALF + wc * 32 + 8 * fq)) = w;
                    }
                }
        }
    }
};
struct EpiVT {
    static constexpr bool PERM = true, AFTER_DRAIN = false;
    const float* ss; bf16_t* VB;
    __device__ __forceinline__ void operator()(const f32x4 (&acc)[2][2][4][2], const Unit& u, int wr, int wc, int fr, int fq) const {
        const int f0 = u.pm * BM + wr * 64 + fr;
#pragma unroll
        for (int bj = 0; bj < 2; ++bj) {
            const int tok0 = u.pn * BM + bj * HALF + wc * 32 + 8 * fq;
            f32x4 r0, r1;
#pragma unroll
            for (int e = 0; e < 4; ++e) { r0[e] = row_rstd(ss, tok0 + e); r1[e] = row_rstd(ss, tok0 + 4 + e); }
            const int b = tok0 >> 12, ch = (tok0 >> 6) & 63, t = tok0 & 63;
#pragma unroll
            for (int ai = 0; ai < 2; ++ai)
#pragma unroll
                for (int m = 0; m < 4; ++m) {
                    const int f = f0 + ai * HALF + m * 16, h = f >> 6, d = f & 63;
                    const u32x4 w = pack8(acc[ai][bj][m][0] * r0, acc[ai][bj][m][1] * r1);
                    *(u32x4*)(VB + ((size_t)((b * 8 + h) * 64 + ch) * 4096 + (t >> 4) * 1024 + d * 16 + (t & 15))) = w;
                }
        }
    }
};
struct EpiRes {
    static constexpr bool PERM = true, AFTER_DRAIN = false;
    const float* base; float* out; bf16_t* XB; float* ssout;
    __device__ __forceinline__ void operator()(const f32x4 (&acc)[2][2][4][2], const Unit& u, int wr, int wc, int fr, int fq) const {
        const int row0 = u.pm * BM + wr * 64 + fr;
#pragma unroll
        for (int ai = 0; ai < 2; ++ai)
#pragma unroll
            for (int m = 0; m < 4; ++m) {
                const int row = row0 + ai * HALF + m * 16; float s = 0.f;
#pragma unroll
                for (int bj = 0; bj < 2; ++bj) {
                    const size_t off = (size_t)row * 1024 + (u.pn * BM + bj * HALF + wc * 32 + 8 * fq);
                    const f32x4 o0 = *(const f32x4*)(base + off) + acc[ai][bj][m][0], o1 = *(const f32x4*)(base + off + 4) + acc[ai][bj][m][1];
                    *(f32x4*)(out + off) = o0; *(f32x4*)(out + off + 4) = o1;
                    *(u32x4*)(XB + off) = pack8(o0, o1);
                    s += dot4(o0) + dot4(o1);
                }
                s += __shfl_xor(s, 16); s += __shfl_xor(s, 32);
                if (fq == 0) ssout[(size_t)row * 16 + u.pn * 4 + wc] = s;
            }
    }
};
struct EpiRelu2 {
    static constexpr bool PERM = true, AFTER_DRAIN = false;
    const float* ss; bf16_t* H;
    __device__ __forceinline__ void operator()(const f32x4 (&acc)[2][2][4][2], const Unit& u, int wr, int wc, int fr, int fq) const {
        const int row0 = u.pm * BM + wr * 64 + fr;
#pragma unroll
        for (int ai = 0; ai < 2; ++ai)
#pragma unroll
            for (int m = 0; m < 4; ++m) {
                const int row = row0 + ai * HALF + m * 16;
                const float rs = row_rstd(ss, row);
#pragma unroll
                for (int bj = 0; bj < 2; ++bj) {
                    f32x4 v0 = acc[ai][bj][m][0] * rs, v1 = acc[ai][bj][m][1] * rs;
#pragma unroll
                    for (int e = 0; e < 4; ++e) { const float a = fmaxf(v0[e], 0.f), c = fmaxf(v1[e], 0.f); v0[e] = a * a; v1[e] = c * c; }
                    *(u32x4*)(H + (size_t)row * 4096 + (u.pn * BM + bj * HALF + wc * 32 + 8 * fq)) = pack8(v0, v1);
                }
            }
    }
};

template <class Epi, class Sched, bool ALIGN_EPI = false, bool SP2 = false>
__device__ __forceinline__ void gemm_phase(PG8_LAS unsigned char* lds, const Gemm g, const Sched& S, const Epi& E) {
    const int tid = opaque_tid(), wid = __builtin_amdgcn_readfirstlane(tid >> 6), lane = tid & 63, wr = wid >> 2, wc = wid & 3, fr = lane & 15, fq = lane >> 4;
    const int K = g.K, nt = K / BK;
    unsigned voffA[2], voffB[2];
#pragma unroll
    for (int i = 0; i < 2; ++i) { int R, C; stage_rc(tid * 16 + i * 8192, R, C); const int Rb = Epi::PERM ? ((R & ~31) + perm32(R & 31)) : R;
        voffA[i] = (unsigned)(R * K + C) * 2u; voffB[i] = (unsigned)(Rb * K + C) * 2u; }
    const size_t kstep = (size_t)(BK * 2);
    const size_t hstep = (size_t)HALF * K * 2;
    const size_t tstep = 2 * hstep;
    const unsigned ldsw = (unsigned)wid * 1024u;
    const int aoff = lds_byte(wr * 64 + fr, fq * 8), boff = lds_byte(wc * 32 + fr, fq * 8);
#define PG8_SA(b, h) (((b) * 2 + (h)) * HTB)
#define PG8_SB(b, h) ((4 + (b) * 2 + (h)) * HTB)
#define PG8_STAGE(bufoff, gbase, voff) do { _Pragma("unroll") for (int _i = 0; _i < 2; ++_i) \
        __builtin_amdgcn_global_load_lds((const unsigned*)((const char*)(gbase) + (voff)[_i]), (PG8_LAS unsigned*)(lds + (bufoff) + ldsw + _i * 8192), 16, 0, 0); } while (0)
#define PG8_LDA(dst, b, h) do { _Pragma("unroll") for (int m = 0; m < 4; ++m) _Pragma("unroll") for (int k = 0; k < 2; ++k) dst[m][k] = *(const PG8_LAS bf16x8*)(lds + PG8_SA(b, h) + aoff + m * 2048 + k * 1024); } while (0)
#define PG8_LDB(dst, b, h) do { _Pragma("unroll") for (int n = 0; n < 2; ++n) _Pragma("unroll") for (int k = 0; k < 2; ++k) dst[n][k] = *(const PG8_LAS bf16x8*)(lds + PG8_SB(b, h) + boff + n * 2048 + k * 1024); } while (0)
#define PG8_MMA(ai, bj, At, Bt) do { __builtin_amdgcn_s_setprio(1); _Pragma("unroll") for (int m = 0; m < 4; ++m) _Pragma("unroll") for (int n = 0; n < 2; ++n) _Pragma("unroll") for (int k = 0; k < 2; ++k) \
        acc[ai][bj][m][n] = __builtin_amdgcn_mfma_f32_16x16x32_bf16(Bt[n][k], At[m][k], acc[ai][bj][m][n], 0, 0, 0); __builtin_amdgcn_s_setprio(0); } while (0)
#define PG8_WAIT_V(n) asm volatile("s_waitcnt vmcnt(" #n ")" ::: "memory")
#define PG8_WAIT_L(n) asm volatile("s_waitcnt lgkmcnt(" #n ")" ::: "memory")
#define PG8_BAR __builtin_amdgcn_s_barrier()
#define PG8_SCHED __builtin_amdgcn_sched_barrier(0)
    Unit cur, nxt; int ui = 0;
    if (!S.next(0, cur)) return;
    f32x4 acc[2][2][4][2];
#pragma unroll
    for (int a = 0; a < 2; ++a)
#pragma unroll
        for (int b = 0; b < 2; ++b)
#pragma unroll
            for (int m = 0; m < 4; ++m)
#pragma unroll
                for (int n = 0; n < 2; ++n) acc[a][b][m][n] = (f32x4){0.f, 0.f, 0.f, 0.f};
    bf16x8 At[4][2], B0[2][2], B1[2][2];
    const char* cA = (const char*)g.A + (size_t)cur.pm * tstep; const char* cB = (const char*)g.Bt + (size_t)cur.pn * tstep;
    S.a_ready(cur);
    if constexpr (SP2) {
        PG8_STAGE(PG8_SB(0, 0), cB, voffB); PG8_STAGE(PG8_SB(0, 1), cB + hstep, voffB); PG8_STAGE(PG8_SA(0, 0), cA, voffA); PG8_STAGE(PG8_SA(0, 1), cA + hstep, voffA);
        if (wr == 1) PG8_BAR;
        PG8_WAIT_V(2); PG8_BAR;
        PG8_STAGE(PG8_SB(1, 0), cB + kstep, voffB); PG8_STAGE(PG8_SA(1, 0), cA + kstep, voffA); PG8_STAGE(PG8_SB(1, 1), cB + hstep + kstep, voffB);
        PG8_WAIT_V(6); PG8_BAR;
    } else {
        PG8_STAGE(PG8_SB(0, 0), cB, voffB); PG8_STAGE(PG8_SA(0, 0), cA, voffA); PG8_STAGE(PG8_SB(0, 1), cB + hstep, voffB); PG8_STAGE(PG8_SA(0, 1), cA + hstep, voffA);
        if (wr == 1) PG8_BAR;
        PG8_WAIT_V(4); PG8_BAR;
        PG8_STAGE(PG8_SB(1, 0), cB + kstep, voffB); PG8_STAGE(PG8_SA(1, 0), cA + kstep, voffA); PG8_STAGE(PG8_SB(1, 1), cB + hstep + kstep, voffB);
        PG8_WAIT_V(6); PG8_BAR;
    }
    for (;;) {
        const bool has_next = S.next(ui + 1, nxt);
        const char* nA = has_next ? (const char*)g.A + (size_t)nxt.pm * tstep : cA; const char* nB = has_next ? (const char*)g.Bt + (size_t)nxt.pn * tstep : cB;
        for (int t = 0; t < nt; t += 2) {
            const bool last = (t == nt - 2);
            const char* a1 = cA + (size_t)(t + 1) * kstep;
            const char* a2 = last ? nA : cA + (size_t)(t + 2) * kstep; const char* b2 = last ? nB : cB + (size_t)(t + 2) * kstep;
            const char* a3 = a2 + kstep; const char* b3 = b2 + kstep;
            if (last && has_next) S.a_ready(nxt);
            if constexpr (SP2) {
            PG8_LDB(B0, 0, 0); PG8_LDB(B1, 0, 1); PG8_SCHED; PG8_LDA(At, 0, 0); PG8_STAGE(PG8_SA(1, 1), a1 + hstep, voffA);
            PG8_WAIT_V(8); PG8_WAIT_L(0); PG8_BAR; PG8_MMA(0, 0, At, B0); PG8_MMA(0, 1, At, B1); PG8_BAR; PG8_SCHED;
            PG8_LDA(At, 0, 1); PG8_STAGE(PG8_SB(0, 0), b2, voffB); PG8_STAGE(PG8_SB(0, 1), b2 + hstep, voffB); PG8_STAGE(PG8_SA(0, 0), a2, voffA);
            PG8_WAIT_V(8); PG8_WAIT_L(0); PG8_BAR; PG8_MMA(1, 0, At, B0); PG8_MMA(1, 1, At, B1); PG8_BAR; PG8_SCHED;
            PG8_LDB(B0, 1, 0); PG8_LDB(B1, 1, 1); PG8_SCHED; PG8_LDA(At, 1, 0); PG8_STAGE(PG8_SA(0, 1), a2 + hstep, voffA);
            PG8_WAIT_V(8); PG8_WAIT_L(0); PG8_BAR; PG8_MMA(0, 0, At, B0); PG8_MMA(0, 1, At, B1); PG8_BAR; PG8_SCHED;
            PG8_LDA(At, 1, 1); PG8_STAGE(PG8_SB(1, 0), b3, voffB); PG8_STAGE(PG8_SB(1, 1), b3 + hstep, voffB); PG8_STAGE(PG8_SA(1, 0), a3, voffA);
            PG8_WAIT_V(8); PG8_WAIT_L(0); PG8_BAR; PG8_MMA(1, 0, At, B0); PG8_MMA(1, 1, At, B1); PG8_BAR; PG8_SCHED;
            } else {
            PG8_LDB(B0, 0, 0); PG8_SCHED; PG8_LDA(At, 0, 0); PG8_STAGE(PG8_SA(1, 1), a1 + hstep, voffA);
            PG8_WAIT_L(8); PG8_BAR; PG8_WAIT_L(0); PG8_MMA(0, 0, At, B0); PG8_BAR; PG8_SCHED;
            PG8_LDB(B1, 0, 1); PG8_STAGE(PG8_SB(0, 0), b2, voffB);
            PG8_BAR; PG8_WAIT_L(0); PG8_MMA(0, 1, At, B1); PG8_BAR;
            PG8_LDA(At, 0, 1); PG8_STAGE(PG8_SA(0, 0), a2, voffA);
            PG8_BAR; PG8_WAIT_L(0); PG8_MMA(1, 0, At, B0); PG8_BAR; PG8_SCHED;
            PG8_STAGE(PG8_SB(0, 1), b2 + hstep, voffB);
            PG8_WAIT_V(6); PG8_BAR; PG8_MMA(1, 1, At, B1); PG8_BAR;
            PG8_LDB(B0, 1, 0); PG8_SCHED; PG8_LDA(At, 1, 0); PG8_STAGE(PG8_SA(0, 1), a2 + hstep, voffA);
            PG8_WAIT_L(8); PG8_BAR; PG8_WAIT_L(0); PG8_MMA(0, 0, At, B0); PG8_BAR; PG8_SCHED;
            PG8_LDB(B1, 1, 1); PG8_STAGE(PG8_SB(1, 0), b3, voffB);
            PG8_BAR; PG8_WAIT_L(0); PG8_MMA(0, 1, At, B1); PG8_BAR;
            PG8_LDA(At, 1, 1); PG8_STAGE(PG8_SA(1, 0), a3, voffA);
            PG8_BAR; PG8_WAIT_L(0); PG8_MMA(1, 0, At, B0); PG8_BAR; PG8_SCHED;
            PG8_STAGE(PG8_SB(1, 1), b3 + hstep, voffB);
            PG8_WAIT_V(6); PG8_BAR; PG8_MMA(1, 1, At, B1); PG8_BAR;
            }
        }
        if constexpr (ALIGN_EPI) { if (wr == 0) PG8_BAR; }
        if constexpr (!Epi::AFTER_DRAIN) { E(acc, cur, wr, wc, fr, fq); S.done(cur); }
        if (!has_next) break;
#pragma unroll
        for (int a = 0; a < 2; ++a)
#pragma unroll
            for (int b = 0; b < 2; ++b)
#pragma unroll
                for (int m = 0; m < 4; ++m)
#pragma unroll
                    for (int n = 0; n < 2; ++n) acc[a][b][m][n] = (f32x4){0.f, 0.f, 0.f, 0.f};
        cur = nxt; cA = nA; cB = nB; ++ui;
        if constexpr (ALIGN_EPI) { if (wr == 1) PG8_BAR; }
    }
    PG8_WAIT_V(0);
    if constexpr (!ALIGN_EPI) { if (wr == 0) PG8_BAR; }
    PG8_BAR;
#undef PG8_SA
#undef PG8_SB
#undef PG8_STAGE
#undef PG8_LDA
#undef PG8_LDB
#undef PG8_MMA
#undef PG8_WAIT_V
#undef PG8_WAIT_L
#undef PG8_BAR
#undef PG8_SCHED
}
}

constexpr int NWAVES = 8;
constexpr int DEPTH = 4, BATCH = 8, SEQ = 4096, D = 1024, M = BATCH * SEQ, DIN = 2560, FF = 4096, NH = 8;
constexpr int LDS_BYTES = 147456;
constexpr size_t MiB = 1u << 20;
constexpr size_t WS_SS = 416 * MiB, SS_BYTES = (size_t)9 * M * 16 * 4;
constexpr size_t WS_BAR = 1536 * 1024, BAR_BYTES = 16384;
constexpr int MISC_OFF = 131072 + 320;
constexpr size_t WS_W = 2 * MiB, W_LAYER = 23 * MiB;
constexpr size_t WO_MAIN = 0, WO_V = 4 * MiB, WO_OUT = 5 * MiB, WO_1 = 7 * MiB, WO_2 = 15 * MiB;
constexpr size_t WS_XB = 96 * MiB;
constexpr size_t WS_QB = 160 * MiB, WS_KB = 192 * MiB, WS_VB = 224 * MiB, WS_R = 256 * MiB, WS_MIX = 320 * MiB;
constexpr size_t WS_H = 160 * MiB;
constexpr size_t WS_END = 440 * MiB;
static_assert(WS_W + DEPTH * W_LAYER <= WS_XB && WS_SS + SS_BYTES <= WS_END, "ws map");

#define LAS __attribute__((address_space(3)))
typedef unsigned short bf16;
typedef unsigned v4u __attribute__((ext_vector_type(4)));
typedef unsigned v2u __attribute__((ext_vector_type(2)));
typedef float f32x4 __attribute__((ext_vector_type(4)));
typedef float f32x16 __attribute__((ext_vector_type(16)));
typedef short bf16x8 __attribute__((ext_vector_type(8)));
#define LDS_WAIT() asm volatile("s_waitcnt lgkmcnt(0)" ::: "memory")

__device__ __forceinline__ unsigned pk2(float lo, float hi) { return pg8::cvt_pk_bf16(lo, hi); }
__device__ __forceinline__ float bflo(unsigned w) { return __uint_as_float(w << 16); }
__device__ __forceinline__ float bfhi(unsigned w) { return __uint_as_float(w & 0xffff0000u); }
__device__ __forceinline__ float wave_sum(float v) {
#pragma unroll
    for (int o = 1; o < 64; o <<= 1) v += __shfl_xor(v, o);
    return v;
}

__device__ __forceinline__ void transpose_item(const float* W, int ldw, int k0, int ncol0, const float* gk, bf16* WT, int K, int drow0, LAS float* scr, int lane) {
    const int kr = lane >> 3, c4 = (lane & 7) * 4;
    f32x4 v[8];
#pragma unroll
    for (int i = 0; i < 8; ++i) v[i] = *(const f32x4*)(W + (size_t)(k0 + 8 * i + kr) * ldw + ncol0 + c4);
    if (gk) {
#pragma unroll
        for (int i = 0; i < 8; ++i) v[i] = v[i] * gk[k0 + 8 * i + kr];
    }
#pragma unroll
    for (int i = 0; i < 8; ++i) { LAS float* d = scr + (8 * i + kr) * 33 + c4; d[0] = v[i][0]; d[1] = v[i][1]; d[2] = v[i][2]; d[3] = v[i][3]; }
    LDS_WAIT(); asm volatile("" ::: "memory");
    const int c = lane & 7;
#pragma unroll
    for (int j = 0; j < 4; ++j) { const int n = (lane >> 3) + 8 * j; const LAS float* s = scr + (8 * c) * 33 + n;
        v4u o; o.x = pk2(s[0 * 33], s[1 * 33]); o.y = pk2(s[2 * 33], s[3 * 33]); o.z = pk2(s[4 * 33], s[5 * 33]); o.w = pk2(s[6 * 33], s[7 * 33]);
        *(v4u*)(WT + (size_t)(drow0 + n) * K + k0 + 8 * c) = o; }
    LDS_WAIT(); asm volatile("" ::: "memory");
}

struct Args { const float* in[13]; float* out; unsigned char* ws; };

__device__ __forceinline__ void prologue(const Args& a, LAS unsigned char* lds) {
    const int tid = pg8::opaque_tid(), lane = tid & 63, wave = __builtin_amdgcn_readfirstlane(tid >> 6);
    LAS float* scr = (LAS float*)(lds + wave * 16384);
    const int gw = blockIdx.x * NWAVES + wave, NGW = gridDim.x * NWAVES;
    constexpr int PER_LAYER = 5760;
    for (int it = gw; it < DEPTH * PER_LAYER; it += NGW) {
        const int l = it / PER_LAYER; int r = it % PER_LAYER;
        unsigned char* wl = a.ws + WS_W + (size_t)l * W_LAYER;
        if (r < 1024) {
            const int kb = r >> 6, db = r & 63, pn = db >> 3, jb = db & 7, bj = jb >> 2, wc = jb & 3;
            const int scol = pn < 4 ? (256 * pn + 64 * wc + 32 * bj) : (1536 + 256 * (pn - 4) + 32 * jb);
            transpose_item(a.in[2] + (size_t)l * D * DIN, DIN, 64 * kb, scol, a.in[1] + l * D, (bf16*)(wl + WO_MAIN), D, 32 * db, scr, lane); continue; }
        r -= 1024;
        if (r < 256) { const int kb = r >> 4, db = r & 15;
            transpose_item(a.in[2] + (size_t)l * D * DIN, DIN, 64 * kb, 1024 + 32 * db, a.in[1] + l * D, (bf16*)(wl + WO_V), D, 32 * db, scr, lane); continue; }
        r -= 256;
        if (r < 384) { const int kb = r >> 5, nb = r & 31;
            transpose_item(a.in[9] + (size_t)l * D * D, D, 64 * kb, 32 * nb, nullptr, (bf16*)(wl + WO_OUT), D, 32 * nb, scr, lane); continue; }
        r -= 384;
        if (r < 2048) { const int kb = r >> 7, nb = r & 127;
            transpose_item(a.in[11] + (size_t)l * D * FF, FF, 64 * kb, 32 * nb, a.in[10] + l * D, (bf16*)(wl + WO_1), D, 32 * nb, scr, lane); continue; }
        r -= 2048;
        { const int kb = r >> 5, nb = r & 31;
            transpose_item(a.in[12] + (size_t)l * FF * D, D, 64 * kb, 32 * nb, nullptr, (bf16*)(wl + WO_2), FF, 32 * nb, scr, lane); }
    }
    for (int it = blockIdx.x * (NWAVES * 64) + tid; it < DEPTH * 4 * 8 * 1024; it += gridDim.x * NWAVES * 64) {
        const int n = it & 1023, cc = (it >> 10) & 7, g = (it >> 13) & 3, l = it >> 15;
        const float* wo = a.in[9] + (size_t)l * D * D + (size_t)(768 + 64 * g) * D + n;
        const float* sc = a.in[8] + l * 256 + 64 * g;
        const float* pw = a.in[7] + ((size_t)(l * 4 + g) * 64 + 8 * cc) * 64;
        float acc[8];
#pragma unroll
        for (int j = 0; j < 8; ++j) acc[j] = 0.f;
        for (int d0 = 0; d0 < 64; d0 += 16) {
            float wv[16];
#pragma unroll
            for (int i = 0; i < 16; ++i) wv[i] = wo[(size_t)(d0 + i) * D];
#pragma unroll
            for (int i = 0; i < 16; ++i) { const float x = wv[i] * sc[d0 + i];
#pragma unroll
                for (int j = 0; j < 8; ++j) acc[j] += pw[j * 64 + d0 + i] * x; }
        }
        v4u o; o.x = pk2(acc[0], acc[1]); o.y = pk2(acc[2], acc[3]); o.z = pk2(acc[4], acc[5]); o.w = pk2(acc[6], acc[7]);
        *(v4u*)((bf16*)(a.ws + WS_W + (size_t)l * W_LAYER + WO_OUT) + (size_t)n * D + 768 + 64 * g + 8 * cc) = o;
    }
    bf16* XB = (bf16*)(a.ws + WS_XB); float* ss0 = (float*)(a.ws + WS_SS);
    for (int m = gw; m < M; m += 2 * NGW) {
        const int m2 = m + NGW;
        const f32x4* xr = (const f32x4*)(a.in[0] + (size_t)m * D) + lane; const f32x4* xr2 = (const f32x4*)(a.in[0] + (size_t)m2 * D) + lane;
        f32x4 v[4], w[4];
#pragma unroll
        for (int j = 0; j < 4; ++j) { v[j] = xr[64 * j]; w[j] = xr2[64 * j]; }
        float s = 0.f, s2 = 0.f;
        unsigned long long* o8 = (unsigned long long*)(XB + (size_t)m * D) + lane; unsigned long long* o82 = (unsigned long long*)(XB + (size_t)m2 * D) + lane;
#pragma unroll
        for (int j = 0; j < 4; ++j) { s += pg8::dot4(v[j]); o8[64 * j] = (unsigned long long)pk2(v[j][0], v[j][1]) | ((unsigned long long)pk2(v[j][2], v[j][3]) << 32);
                                      s2 += pg8::dot4(w[j]); o82[64 * j] = (unsigned long long)pk2(w[j][0], w[j][1]) | ((unsigned long long)pk2(w[j][2], w[j][3]) << 32); }
        s = wave_sum(s); s2 = wave_sum(s2);
        if (lane < 16) { ss0[(size_t)m * 16 + lane] = lane == 0 ? s : 0.f; ss0[(size_t)m2 * 16 + lane] = lane == 0 ? s2 : 0.f; }
    }
}

__device__ __forceinline__ float max3f(float a, float b, float c) { return fmaxf(fmaxf(a, b), c); }
__device__ __forceinline__ float swap32_max(float m) { auto rr = __builtin_amdgcn_permlane32_swap(__float_as_uint(m), __float_as_uint(m), false, false); return fmaxf(__uint_as_float(rr[0]), __uint_as_float(rr[1])); }
__device__ __forceinline__ float swap32_sum(float m) { auto rr = __builtin_amdgcn_permlane32_swap(__float_as_uint(m), __float_as_uint(m), false, false); return __uint_as_float(rr[0]) + __uint_as_float(rr[1]); }
typedef float f32x2_t __attribute__((ext_vector_type(2))); typedef __bf16 bf16x2_t __attribute__((ext_vector_type(2)));
__device__ __forceinline__ unsigned cvtpk_s(float lo, float hi) { f32x2_t v = {lo, hi}; bf16x2_t b = __builtin_convertvector(v, bf16x2_t); return __builtin_bit_cast(unsigned, b); }

__device__ __forceinline__ void attn_load_k(bf16x8 (&kf)[2][4], const bf16* kb, int koff) {
#pragma unroll
    for (int hf = 0; hf < 2; ++hf)
#pragma unroll
        for (int d0 = 0; d0 < 4; ++d0) kf[hf][d0] = *(const bf16x8*)(kb + d0 * 1024 + hf * 512 + koff);
}
__device__ __forceinline__ void attn_load_v(bf16x8 (&vf)[2][4], const bf16* vb, int voff) {
#pragma unroll
    for (int dh = 0; dh < 2; ++dh)
#pragma unroll
        for (int s = 0; s < 4; ++s) vf[dh][s] = *(const bf16x8*)(vb + s * 1024 + dh * 512 + voff);
}
__device__ __forceinline__ void attn_tile(const bf16x8 (&kf)[2][4], const bf16x8 (&vf)[2][4], const bf16x8 (&qr)[4], int j, int qi, int hi, const LAS float* tb, float cb,
                                          float& mrun, float& l, f32x16& o0, f32x16& o1) {
    const float c0 = (j <= 5) ? cb : 0.f;
    f32x16 p0, p1;
#pragma unroll
    for (int r = 0; r < 16; ++r) { p0[r] = c0; p1[r] = c0; }
#pragma unroll
    for (int d0 = 0; d0 < 4; ++d0) { p0 = __builtin_amdgcn_mfma_f32_32x32x16_bf16(kf[0][d0], qr[d0], p0, 0, 0, 0); p1 = __builtin_amdgcn_mfma_f32_32x32x16_bf16(kf[1][d0], qr[d0], p1, 0, 0, 0); }
    if (j >= 6) {
        const int base = qi + 64 * (8 - j) + 128 - 8 * hi;
#pragma unroll
        for (int r = 0; r < 16; ++r) { const int key = (r >> 3) * 16 + (r & 7); int i0 = base - key, i1 = base - key - 32; i0 = i0 > 256 ? 256 : i0; i1 = i1 > 256 ? 256 : i1; p0[r] += tb[i0]; p1[r] += tb[i1]; }
    }
    float rm = max3f(p0[0], p0[1], p1[0]);
#pragma unroll
    for (int r = 1; r < 16; ++r) rm = max3f(rm, p0[r], p1[r]);
    rm = fmaxf(rm, p0[0]); rm = swap32_max(rm);
    const float mnew = fmaxf(mrun, rm), alpha = __builtin_amdgcn_exp2f(mrun - mnew); mrun = mnew;
    float rsum = 0.f;
#pragma unroll
    for (int r = 0; r < 16; ++r) { p0[r] = __builtin_amdgcn_exp2f(p0[r] - mnew); p1[r] = __builtin_amdgcn_exp2f(p1[r] - mnew); rsum += p0[r] + p1[r]; }
    l = l * alpha + rsum;
#pragma unroll
    for (int r = 0; r < 16; ++r) { o0[r] *= alpha; o1[r] *= alpha; }
    v4u pw[4];
#pragma unroll
    for (int s = 0; s < 2; ++s) {
        pw[s] = (v4u){cvtpk_s(p0[8 * s + 0], p0[8 * s + 1]), cvtpk_s(p0[8 * s + 2], p0[8 * s + 3]), cvtpk_s(p0[8 * s + 4], p0[8 * s + 5]), cvtpk_s(p0[8 * s + 6], p0[8 * s + 7])};
        pw[2 + s] = (v4u){cvtpk_s(p1[8 * s + 0], p1[8 * s + 1]), cvtpk_s(p1[8 * s + 2], p1[8 * s + 3]), cvtpk_s(p1[8 * s + 4], p1[8 * s + 5]), cvtpk_s(p1[8 * s + 6], p1[8 * s + 7])};
    }
#pragma unroll
    for (int s = 0; s < 4; ++s) { const bf16x8 pf = __builtin_bit_cast(bf16x8, pw[s]);
        o0 = __builtin_amdgcn_mfma_f32_32x32x16_bf16(vf[0][s], pf, o0, 0, 0, 0); o1 = __builtin_amdgcn_mfma_f32_32x32x16_bf16(vf[1][s], pf, o1, 0, 0, 0); }
}
__device__ __forceinline__ void attn_wave_unit(int b, int h, int n, int half, const bf16* QB, const bf16* KB, const bf16* VB, bf16* MIX, const LAS float* tab, int lane) {
    const int r32 = lane & 31, hi = lane >> 5;
    const size_t tok = (size_t)b * SEQ + n * 64 + half * 32 + r32;
    bf16x8 qr[4];
#pragma unroll
    for (int d0 = 0; d0 < 4; ++d0) qr[d0] = *(const bf16x8*)(QB + tok * 512 + h * 64 + d0 * 16 + hi * 8);
    const int pk = (r32 & 19) | ((r32 & 4) << 1) | ((r32 & 8) >> 1);
    const int koff = pk * 16 + hi * 8, voff = r32 * 16 + hi * 8;
    float mrun = -1e30f, l = 0.f; f32x16 o0 = f32x16{}, o1 = f32x16{};
    const LAS float* tb = tab + h * 260;
    const float cb = tb[256];
    const int qi = half * 32 + r32;
    int j = (n < 8 ? 8 - n : 0);
    const bf16* kb = KB + (size_t)((b * NH + h) * 64 + (n + j - 8)) * 4096; const bf16* vb = VB + (size_t)((b * NH + h) * 64 + (n + j - 8)) * 4096;
    bf16x8 kfA[2][4], kfB[2][4], vf[2][4];
    attn_load_k(kfA, kb, koff); attn_load_v(vf, vb, voff);
    for (;;) {
        kb += 4096; vb += 4096;
        if (j < 8) attn_load_k(kfB, kb, koff);
        attn_tile(kfA, vf, qr, j, qi, hi, tb, cb, mrun, l, o0, o1);
        if (++j > 8) break;
        attn_load_v(vf, vb, voff);
        kb += 4096; vb += 4096;
        if (j < 8) attn_load_k(kfA, kb, koff);
        attn_tile(kfB, vf, qr, j, qi, hi, tb, cb, mrun, l, o0, o1);
        if (++j > 8) break;
        attn_load_v(vf, vb, voff);
    }
    const float linv = 1.f / swap32_sum(l);
    bf16* orow = MIX + tok * 1024 + h * 64 + 4 * hi;
#pragma unroll
    for (int r4 = 0; r4 < 4; ++r4) {
        v2u w0, w1;
        w0.x = cvtpk_s(o0[4 * r4] * linv, o0[4 * r4 + 1] * linv); w0.y = cvtpk_s(o0[4 * r4 + 2] * linv, o0[4 * r4 + 3] * linv);
        w1.x = cvtpk_s(o1[4 * r4] * linv, o1[4 * r4 + 1] * linv); w1.y = cvtpk_s(o1[4 * r4 + 2] * linv, o1[4 * r4 + 3] * linv);
        *(v2u*)(orow + 8 * r4) = w0; *(v2u*)(orow + 32 + 8 * r4) = w1;
    }
}

__device__ __forceinline__ void unpack8(const v4u w, float (&f)[8]) { f[0] = bflo(w.x); f[1] = bfhi(w.x); f[2] = bflo(w.y); f[3] = bfhi(w.y); f[4] = bflo(w.z); f[5] = bfhi(w.z); f[6] = bflo(w.w); f[7] = bfhi(w.w); }

__device__ __forceinline__ void mixer_phase(const Args& a, int l, LAS unsigned char* lds) {
    const int tid = pg8::opaque_tid(), lane = tid & 63, wave = __builtin_amdgcn_readfirstlane(tid >> 6);
    const bf16* QB = (const bf16*)(a.ws + WS_QB); const bf16* KB = (const bf16*)(a.ws + WS_KB); const bf16* VB = (const bf16*)(a.ws + WS_VB);
    const bf16* R = (const bf16*)(a.ws + WS_R); bf16* MIX = (bf16*)(a.ws + WS_MIX);
    LAS float* tab = (LAS float*)lds;
    { const float* rb = a.in[5] + (size_t)l * NH * 257;
      for (int i = tid; i < NH * 257; i += NWAVES * 64) { const int h = i / 257, e = i % 257; tab[h * 260 + e] = rb[i] * 1.4426950408889634f; } }
    __syncthreads();
    const int gw = blockIdx.x * NWAVES + wave, NGW = gridDim.x * NWAVES;
    for (int u = gw; u < BATCH * NH * 64 * 2; u += NGW) {
        const int half = u & 1, h = (u >> 1) & 7, n = (u >> 4) & 63, b = u >> 10;
        attn_wave_unit(b, h, n, half, QB, KB, VB, MIX, tab, lane);
    }
    const int gt = blockIdx.x * (NWAVES * 64) + tid, NGT = gridDim.x * NWAVES * 64;
    for (int it = gt; it < 131072; it += NGT) {
        const int type = it >> 16, vec = it & 31, run = (it & 65535) >> 5;
        const size_t tok0 = (size_t)run * 16; const int tpos0 = (int)(tok0 & (SEQ - 1)); const int c = vec * 8;
        if (type == 0) {
            const float* cw = a.in[6] + (size_t)l * 3 * 256 + c;
            float w0[8], w1[8], w2[8], zp2[8], zp1[8];
            { const f32x4 x0 = *(const f32x4*)(cw), x1 = *(const f32x4*)(cw + 4), y0 = *(const f32x4*)(cw + 256), y1 = *(const f32x4*)(cw + 260), z0 = *(const f32x4*)(cw + 512), z1 = *(const f32x4*)(cw + 516);
#pragma unroll
              for (int e = 0; e < 4; ++e) { w0[e] = x0[e]; w0[4 + e] = x1[e]; w1[e] = y0[e]; w1[4 + e] = y1[e]; w2[e] = z0[e]; w2[4 + e] = z1[e]; } }
            if (tpos0 >= 2) {
                float g1[8], h1[8], g2[8], h2[8];
                unpack8(*(const v4u*)(R + (tok0 - 2) * 1024 + 256 + c), g2); unpack8(*(const v4u*)(R + (tok0 - 2) * 1024 + 512 + c), h2);
                unpack8(*(const v4u*)(R + (tok0 - 1) * 1024 + 256 + c), g1); unpack8(*(const v4u*)(R + (tok0 - 1) * 1024 + 512 + c), h1);
#pragma unroll
                for (int e = 0; e < 8; ++e) { zp2[e] = g2[e] * h2[e]; zp1[e] = g1[e] * h1[e]; }
            } else {
#pragma unroll
                for (int e = 0; e < 8; ++e) { zp2[e] = 0.f; zp1[e] = 0.f; }
            }
            for (int t4 = 0; t4 < 16; t4 += 4) {
                v4u rgb[4], rgc[4], rhn[4];
#pragma unroll
                for (int t = 0; t < 4; ++t) { const bf16* rr = R + (tok0 + t4 + t) * 1024 + c; rgb[t] = *(const v4u*)(rr); rgc[t] = *(const v4u*)(rr + 256); rhn[t] = *(const v4u*)(rr + 512); }
#pragma unroll
                for (int t = 0; t < 4; ++t) {
                    float gb[8], gc[8], hn[8], y[8];
                    unpack8(rgb[t], gb); unpack8(rgc[t], gc); unpack8(rhn[t], hn);
#pragma unroll
                    for (int e = 0; e < 8; ++e) { const float z = gc[e] * hn[e]; y[e] = gb[e] * (w0[e] * zp2[e] + w1[e] * zp1[e] + w2[e] * z); zp2[e] = zp1[e]; zp1[e] = z; }
                    v4u o; o.x = pk2(y[0], y[1]); o.y = pk2(y[2], y[3]); o.z = pk2(y[4], y[5]); o.w = pk2(y[6], y[7]);
                    *(v4u*)(MIX + (tok0 + t4 + t) * 1024 + 512 + c) = o;
                }
            }
        } else {
            const int w = 2 << (vec >> 3);
            const bf16* ub = R + 768 + c;
            float S[8];
#pragma unroll
            for (int e = 0; e < 8; ++e) S[e] = 0.f;
            if (tpos0 > 0) {
                for (int j = 1; j < w; ++j) { float uu[8]; unpack8(*(const v4u*)(ub + (tok0 - j) * 1024), uu);
#pragma unroll
                    for (int e = 0; e < 8; ++e) S[e] += uu[e]; }
            }
            for (int t4 = 0; t4 < 16; t4 += 4) {
                v4u ru[4], ro[4];
#pragma unroll
                for (int t = 0; t < 4; ++t) { ru[t] = *(const v4u*)(ub + (tok0 + t4 + t) * 1024);
                    const int tpo = tpos0 + t4 + t - (w - 1);
                    ro[t] = *(const v4u*)(ub + (tok0 + t4 + t - (tpo >= 0 ? (w - 1) : 0)) * 1024); }
#pragma unroll
                for (int t = 0; t < 4; ++t) {
                    float ut[8], uo[8], mm[8]; unpack8(ru[t], ut); unpack8(ro[t], uo);
                    const int tp = tpos0 + t4 + t; const float rc = 1.f / (float)(tp + 1 < w ? tp + 1 : w);
                    const bool drop = tp - (w - 1) >= 0;
#pragma unroll
                    for (int e = 0; e < 8; ++e) { S[e] += ut[e]; mm[e] = S[e] * rc - ut[e]; S[e] -= drop ? uo[e] : 0.f; }
                    v4u o; o.x = pk2(mm[0], mm[1]); o.y = pk2(mm[2], mm[3]); o.z = pk2(mm[4], mm[5]); o.w = pk2(mm[6], mm[7]);
                    *(v4u*)(MIX + (tok0 + t4 + t) * 1024 + 768 + c) = o;
                }
            }
        }
    }
    __syncthreads();
}

#define XB_TMO      128
#define XB_XCNT(j)  (256  + 64 * (j))
#define XB_XSUB(j)  (1280 + 64 * (j))
#define XB_XGEN(j)  (2304 + 64 * (j))
#define XB_TOP      3328
#define XB_TOPGEN   3392
#define XCD_BAR_WORDS 3456
#define XB_SPIN_CAP (1u << 22)
__device__ __forceinline__ unsigned xb_ld(unsigned* p)              { return __hip_atomic_load(p, __ATOMIC_RELAXED, __HIP_MEMORY_SCOPE_AGENT); }
__device__ __forceinline__ unsigned xb_add(unsigned* p, unsigned v) { return __hip_atomic_fetch_add(p, v, __ATOMIC_RELAXED, __HIP_MEMORY_SCOPE_AGENT); }
__device__ __forceinline__ unsigned xb_xcc_id() { return (unsigned)__builtin_amdgcn_s_getreg((3 << 11) | 20) & 0xFu; }
#define XB_SPIN(cond, bar) do { unsigned _sp = 0; while (cond) { __builtin_amdgcn_s_sleep(1); \
    if ((++_sp & 255u) == 0u) { if (xb_ld(&(bar)[XB_TMO])) break; if (_sp > XB_SPIN_CAP) { atomicAdd(&(bar)[XB_TMO], 1u); break; } } } } while (0)
struct XcdBarrier { unsigned* bar; unsigned x; volatile LAS unsigned* st; };
__device__ __forceinline__ XcdBarrier xcd_barrier_post(unsigned* bar, volatile LAS unsigned* st) {
    XcdBarrier b; b.bar = bar; b.x = xb_xcc_id(); b.st = st;
    if (threadIdx.x == 0) (void)xb_add(&bar[XB_XCNT(b.x)], 1u);
    return b;
}
__device__ __forceinline__ void xcd_barrier_complete(unsigned* bar, unsigned x, unsigned& nloc, unsigned& nx) {
    const unsigned G = gridDim.x * gridDim.y * gridDim.z;
    unsigned sum, cnt, mine, sp = 0u;
    for (;;) {
        sum = 0u; cnt = 0u; mine = 0u;
#pragma unroll
        for (unsigned j = 0; j < 16; ++j) { const unsigned c = xb_ld(&bar[XB_XCNT(j)]); sum += c; cnt += (c > 0u) ? 1u : 0u; mine = (j == x) ? c : mine; }
        if (sum == G) break;
        __builtin_amdgcn_s_sleep(1);
        if ((++sp & 255u) == 0u) { if (xb_ld(&bar[XB_TMO])) break; if (sp > XB_SPIN_CAP) { atomicAdd(&bar[XB_TMO], 1u); break; } }
    }
    nloc = mine > 0u ? mine : 1u; nx = cnt > 0u ? cnt : 1u;
}
__device__ __forceinline__ void xcd_barrier(const XcdBarrier& b) {
    asm volatile("s_waitcnt vmcnt(0)" ::: "memory");
    __syncthreads();
    if (threadIdx.x == 0) {
        unsigned* bar = b.bar;
        __builtin_amdgcn_s_waitcnt(0);
        unsigned nloc = b.st[0], nx = b.st[1];
        if (nloc == 0u) { xcd_barrier_complete(bar, b.x, nloc, nx); b.st[0] = nloc; b.st[1] = nx; }
        const unsigned old = xb_add(&bar[XB_XSUB(b.x)], 1u);
        const unsigned gen = old / nloc;
        if (old + 1u == (gen + 1u) * nloc) {
            __builtin_amdgcn_fence(__ATOMIC_RELEASE, "agent");
            asm volatile("s_waitcnt vmcnt(0)" ::: "memory");
            const unsigned og = xb_add(&bar[XB_TOP], 1u);
            const unsigned tg = og / nx;
            if (og + 1u == (tg + 1u) * nx) xb_add(&bar[XB_TOPGEN], 1u);
            else XB_SPIN(xb_ld(&bar[XB_TOPGEN]) == tg, bar);
            __builtin_amdgcn_fence(__ATOMIC_ACQUIRE, "agent");
            xb_add(&bar[XB_XGEN(b.x)], 1u);
            asm volatile("s_waitcnt vmcnt(0)" ::: "memory");
        } else {
            XB_SPIN(xb_ld(&bar[XB_XGEN(b.x)]) == gen, bar);
            __builtin_amdgcn_fence(__ATOMIC_ACQUIRE, "agent");
            asm volatile("s_waitcnt vmcnt(0)" ::: "memory");
        }
    }
    __syncthreads();
}
#define gsync(grid) do { XcdBarrier b_; b_.bar = (unsigned*)(a.ws + WS_BAR); b_.x = xb_xcc_id(); b_.st = (volatile LAS unsigned*)(lds + MISC_OFF) + 8; xcd_barrier(b_); } while (0)
__global__ void __launch_bounds__(NWAVES * 64, 2) fwd_megakernel(Args a) {
    extern __shared__ __attribute__((aligned(16))) unsigned char lds_raw[];
    LAS unsigned char* lds = (LAS unsigned char*)lds_raw;
    cg::grid_group grid = cg::this_grid();
    const int G = gridDim.x;
    unsigned char* ws = a.ws;
    float* ss = (float*)(ws + WS_SS);
    bf16* XB = (bf16*)(ws + WS_XB); bf16* QB = (bf16*)(ws + WS_QB); bf16* KB = (bf16*)(ws + WS_KB); bf16* VB = (bf16*)(ws + WS_VB);
    bf16* R = (bf16*)(ws + WS_R); bf16* MIX = (bf16*)(ws + WS_MIX); bf16* HB = (bf16*)(ws + WS_H);

    volatile LAS unsigned* MISC = (volatile LAS unsigned*)(lds + MISC_OFF);
    if (threadIdx.x < 32) MISC[threadIdx.x] = 0u;
    __syncthreads();
    (void)xcd_barrier_post((unsigned*)(ws + WS_BAR), MISC + 8);
    grid.sync();
    prologue(a, lds);
    gsync(grid);

    for (int l = 0; l < DEPTH; ++l) {
        unsigned char* wl = ws + WS_W + (size_t)l * W_LAYER;
        const float* ss1 = ss + (size_t)(2 * l) * M * 16; float* ss2 = ss + (size_t)(2 * l + 1) * M * 16; float* ss3 = ss + (size_t)(2 * l + 2) * M * 16;
        {
            pg8::Gemm g{XB, (const bf16*)(wl + WO_MAIN), M, 2048, D}; pg8::StaticOrder S; S.init(M, 2048, G, (int)blockIdx.x);
            pg8::EpiIn E{ss1, QB, KB, R, a.in[3] + l * 64, a.in[4] + l * 64};
            pg8::gemm_phase<pg8::EpiIn, pg8::StaticOrder, true, true>(lds, g, S, E);
            pg8::Gemm g2{(const bf16*)(wl + WO_V), XB, 512, M, D}; pg8::StaticOrder S2; S2.init(512, M, G, (int)blockIdx.x);
            pg8::EpiVT E2{ss1, VB};
            pg8::gemm_phase<pg8::EpiVT, pg8::StaticOrder, true, true>(lds, g2, S2, E2);
        }
        gsync(grid);
        mixer_phase(a, l, lds);
        gsync(grid);
        {
            pg8::Gemm g{MIX, (const bf16*)(wl + WO_OUT), M, D, D}; pg8::StaticOrder S; S.init(M, D, G, (int)blockIdx.x);
            pg8::EpiRes E{l == 0 ? a.in[0] : a.out, a.out, XB, ss2};
            pg8::gemm_phase<pg8::EpiRes, pg8::StaticOrder, true, true>(lds, g, S, E);
        }
        gsync(grid);
        {
            pg8::Gemm g{XB, (const bf16*)(wl + WO_1), M, FF, D}; pg8::StaticOrder S; S.init(M, FF, G, (int)blockIdx.x);
            pg8::EpiRelu2 E{ss2, HB};
            pg8::gemm_phase<pg8::EpiRelu2, pg8::StaticOrder, true, true>(lds, g, S, E);
        }
        gsync(grid);
        {
            pg8::Gemm g{HB, (const bf16*)(wl + WO_2), M, D, FF}; pg8::StaticOrder S; S.init(M, D, G, (int)blockIdx.x);
            pg8::EpiRes E{a.out, a.out, XB, ss3};
            pg8::gemm_phase<pg8::EpiRes, pg8::StaticOrder, true, true>(lds, g, S, E);
        }
        if (l + 1 < DEPTH) gsync(grid);
    }
}

extern "C" void kernel_launch(void* const* d_in, const int* in_sizes, int n_in, void* d_out, int out_size, void* d_ws, size_t ws_size, hipStream_t stream) {
    static int grid = 0;
    if (grid == 0) {
        if (n_in != 13 || in_sizes[0] != M * D || out_size != M * D || ws_size < WS_END) { fprintf(stderr, "kernel_launch: unexpected shapes (n_in %d, in0 %d, out %d, ws %zu)\n", n_in, n_in > 0 ? in_sizes[0] : -1, out_size, ws_size); grid = -1; return; }
        int dev = 0, cus = 0, per_cu = 0;
        (void)hipGetDevice(&dev); (void)hipDeviceGetAttribute(&cus, hipDeviceAttributeMultiprocessorCount, dev);
        if (hipFuncSetAttribute((const void*)fwd_megakernel, hipFuncAttributeMaxDynamicSharedMemorySize, LDS_BYTES) != hipSuccess) { fprintf(stderr, "kernel_launch: hipFuncSetAttribute failed\n"); grid = -1; return; }
        if (hipOccupancyMaxActiveBlocksPerMultiprocessor(&per_cu, (const void*)fwd_megakernel, NWAVES * 64, LDS_BYTES) != hipSuccess || per_cu < 1) { fprintf(stderr, "kernel_launch: occupancy query says %d\n", per_cu); per_cu = 1; }
        (void)hipGetLastError();
        grid = cus;
    }
    if (grid < 0) return;
    (void)hipMemsetAsync((char*)d_ws + WS_BAR, 0, BAR_BYTES, stream);
    Args a{};
    for (int i = 0; i < 13; ++i) a.in[i] = (const float*)d_in[i];
    a.out = (float*)d_out; a.ws = (unsigned char*)d_ws;
    void* args[] = {&a};
    hipError_t e = hipLaunchCooperativeKernel((const void*)fwd_megakernel, dim3(grid), dim3(NWAVES * 64), args, LDS_BYTES, stream);
    if (e != hipSuccess) fprintf(stderr, "cooperative launch failed: %s (grid %d)\n", hipGetErrorString(e), grid);
}
```

```cpp
#include <hip/hip_runtime.h>
#include <hip/hip_cooperative_groups.h>
#include <cstdio>
#include <cstdint>
namespace cg = cooperative_groups;

namespace pg8 {
#define PG8_LAS __attribute__((address_space(3)))
typedef unsigned short bf16_t;
typedef short bf16x8 __attribute__((ext_vector_type(8)));
typedef float f32x4 __attribute__((ext_vector_type(4)));
typedef unsigned u32x4 __attribute__((ext_vector_type(4)));
typedef unsigned u32x2 __attribute__((ext_vector_type(2)));
constexpr int BM = 256, BK = 64, HALF = 128, HTB = HALF * BK * 2  , STAGE_BYTES = 8 * HTB, NXCD = 8, WGM = 8;

__host__ __device__ __forceinline__ int lds_byte(int r, int c) { const int st = (r >> 4) * 2 + (c >> 5), rr = r & 15, cc = c & 31, ob = rr * 64 + cc * 2; return st * 1024 + (ob ^ (((ob >> 9) & 1) << 5)); }
__host__ __device__ __forceinline__ void stage_rc(int b, int& R, int& C) { const int st = b / 1024, sb = b % 1024, swz = sb ^ (((sb >> 9) & 1) << 5); R = (st >> 1) * 16 + swz / 64; C = (st & 1) * 32 + (swz % 64) / 2; }
__host__ __device__ __forceinline__ int perm32(int rho) { const int n = rho >> 4, i = rho & 15; return 8 * (i >> 2) + 4 * n + (i & 3); }

struct Unit { int pm, pn; };
struct Gemm { const bf16_t* A; const bf16_t* Bt; int M, N, K; size_t a_bstride; };

struct StaticOrder {
    int nM, nN, nwg, G, c, remap, pmo, pno;
    __host__ __device__ void init(int nM_, int nN_, int G_, int c_, int remap_, int pmo_, int pno_) { nM = nM_; nN = nN_; nwg = nM * nN; G = G_; c = c_; remap = remap_; pmo = pmo_; pno = pno_; }
    __host__ __device__ bool next(int i, Unit& u) const {
        const long L = (long)i * G + c; if (L >= nwg) return false;
        int wgid = (int)L; if (remap) { const int q = nwg / NXCD, r = nwg % NXCD, xcd = wgid % NXCD, off = wgid / NXCD; wgid = (xcd < r ? xcd * (q + 1) : r * (q + 1) + (xcd - r) * q) + off; }
        const int nig = WGM * nN, gid = wgid / nig, fm = gid * WGM, gsz = (nM - fm) < WGM ? (nM - fm) : WGM;
        u.pm = pmo + fm + ((wgid % nig) % gsz); u.pn = pno + (wgid % nig) / gsz; return true;
    }
    __device__ __forceinline__ void a_ready(const Unit&) const {}
    __device__ __forceinline__ void done(const Unit&) const {}
};

__device__ __forceinline__ int lane_id() { int l; asm volatile("v_mbcnt_lo_u32_b32 %0, -1, 0\n\tv_mbcnt_hi_u32_b32 %0, -1, %0" : "=v"(l)); return l; }
__device__ __forceinline__ int opaque_tid(int ws) { return ws * 64 + lane_id(); }
__device__ __forceinline__ unsigned cvt_pk_bf16(float lo, float hi) { unsigned r; asm volatile("v_cvt_pk_bf16_f32 %0, %1, %2" : "=v"(r) : "v"(lo), "v"(hi)); return r; }
__device__ __forceinline__ u32x4 pack8(const f32x4& v0, const f32x4& v1) { u32x4 w; w.x = cvt_pk_bf16(v0[0], v0[1]); w.y = cvt_pk_bf16(v0[2], v0[3]); w.z = cvt_pk_bf16(v1[0], v1[1]); w.w = cvt_pk_bf16(v1[2], v1[3]); return w; }
__device__ __forceinline__ float fmul_s(float a, float b) { float r; asm("v_mul_f32_e32 %0, %1, %2" : "=v"(r) : "v"(a), "v"(b)); return r; }
__device__ __forceinline__ float dot4(const f32x4& v) { return (v[0] * v[0] + v[1] * v[1]) + (v[2] * v[2] + v[3] * v[3]); }

constexpr float EPS = 1e-6f;
constexpr size_t SLAB_E = (size_t)16 << 20;

__device__ __forceinline__ float row_rstd(const float* ssp, int row) {
    const f32x4 a = *(const f32x4*)(ssp + (size_t)row * 4);
    const float s = (a[0] + a[1]) + (a[2] + a[3]);
    return rsqrtf(s * (1.f / 1024.f) + EPS);
}

__device__ __forceinline__ void rstd_prefetch(const float* ssp, int row0, PG8_LAS unsigned char* lr, int ui, int wid, int lane) {
    if (wid < 4) __builtin_amdgcn_global_load_lds((const unsigned*)(ssp + (size_t)(row0 + wid * 64 + lane) * 4), (PG8_LAS unsigned*)(lr + (ui & 1) * 4096 + wid * 1024), 16, 0, 0);
}
__device__ __forceinline__ float row_rstd_lds(const PG8_LAS unsigned char* lr, int ui, int r) {
    const f32x4 a = *(const PG8_LAS f32x4*)(lr + (ui & 1) * 4096 + r * 16);
    const float s = (a[0] + a[1]) + (a[2] + a[3]);
    return rsqrtf(s * (1.f / 1024.f) + EPS);
}
constexpr float QSCALE = 0.125f * 1.4426950408889634f;

struct EpiIn {
    static constexpr bool PERM = true, AFTER_DRAIN = false;
    const float* ss; bf16_t* QB; bf16_t* KB; bf16_t* R; PG8_LAS unsigned char* lr;
    __device__ __forceinline__ void prefetch(const Unit& u, int ui, int wid, int lane) const { rstd_prefetch(ss, u.pm * BM, lr, ui, wid, lane); }
    __device__ __forceinline__ void operator()(const f32x4 (&acc)[2][2][4][2], const Unit& u, int wr, int wc, int fr, int fq, int ui) const {
        const int row0 = u.pm * BM + wr * 64 + fr, rl0 = wr * 64 + fr;
        if (u.pn < 4) {
            const bool isq = u.pn < 2;
            const PG8_LAS float* gp = (const PG8_LAS float*)(lr + 8192) + (isq ? 0 : 64);
            f32x4 gv[2][2];
#pragma unroll
            for (int bj = 0; bj < 2; ++bj)
#pragma unroll
                for (int n = 0; n < 2; ++n) gv[bj][n] = *(const PG8_LAS f32x4*)(gp + 32 * bj + 8 * fq + 4 * n);
            const float post = isq ? QSCALE : 1.f;
#pragma unroll
            for (int ai = 0; ai < 2; ++ai)
#pragma unroll
                for (int m = 0; m < 4; ++m) {
                    const int row = row0 + ai * HALF + m * 16;
                    const float rs = row_rstd_lds(lr, ui, rl0 + ai * HALF + m * 16);
                    f32x4 v[2][2]; float s = 0.f;
#pragma unroll
                    for (int bj = 0; bj < 2; ++bj)
#pragma unroll
                        for (int n = 0; n < 2; ++n) { v[bj][n] = acc[ai][bj][m][n] * rs; s += dot4(v[bj][n]); }
                    s += __shfl_xor(s, 16); s += __shfl_xor(s, 32);
                    const float hr = rsqrtf(s * (1.f / 64.f) + EPS) * post;
#pragma unroll
                    for (int bj = 0; bj < 2; ++bj) {
                        const f32x4 v0 = v[bj][0] * hr * gv[bj][0], v1 = v[bj][1] * hr * gv[bj][1];
                        const u32x4 w = pack8(v0, v1);
                        if (isq) { *(u32x4*)(QB + (size_t)(row >> 12) * SLAB_E + (size_t)(row & 4095) * 512 + (u.pn * 256 + 64 * wc + 32 * bj + 8 * fq)) = w; }
                        else {
                            const int h = (u.pn - 2) * 4 + wc, b = row >> 12, ch = (row >> 6) & 63, key = row & 63, dcol = 32 * bj + 8 * fq;
                            const int k5 = key & 31, rho = (k5 & 19) | ((k5 & 4) << 1) | ((k5 & 8) >> 1);
                            *(u32x4*)(KB + ((size_t)b * SLAB_E + (size_t)(h * 64 + ch) * 4096 + (dcol >> 4) * 1024 + (key >> 5) * 512 + ((dcol >> 3) & 1) * 256 + rho * 8)) = w;
                        }
                    }
                }
        } else {
#pragma unroll
            for (int ai = 0; ai < 2; ++ai)
#pragma unroll
                for (int m = 0; m < 4; ++m) {
                    const int row = row0 + ai * HALF + m * 16;
                    const float rs = row_rstd_lds(lr, ui, rl0 + ai * HALF + m * 16);
#pragma unroll
                    for (int bj = 0; bj < 2; ++bj) {
                        const u32x4 w = pack8(acc[ai][bj][m][0] * rs, acc[ai][bj][m][1] * rs);
                        __builtin_nontemporal_store(w, (u32x4*)(R + (size_t)(row >> 12) * SLAB_E + (size_t)(row & 4095) * 1024 + ((u.pn - 4) * 256 + bj * HALF + wc * 32 + 8 * fq)));
                    }
                }
        }
    }
};
struct EpiVT {
    static constexpr bool PERM = true, AFTER_DRAIN = false;
    const float* ss; bf16_t* VB; PG8_LAS unsigned char* lr;
    __device__ __forceinline__ void prefetch(const Unit& u, int ui, int wid, int lane) const { rstd_prefetch(ss, u.pn * BM, lr, ui, wid, lane); }
    __device__ __forceinline__ void operator()(const f32x4 (&acc)[2][2][4][2], const Unit& u, int wr, int wc, int fr, int fq, int ui) const {
        const int f0 = u.pm * BM + wr * 64 + fr;
#pragma unroll
        for (int bj = 0; bj < 2; ++bj) {
            const int tok0 = u.pn * BM + bj * HALF + wc * 32 + 8 * fq;
            f32x4 r0, r1;
#pragma unroll
            for (int e = 0; e < 4; ++e) { r0[e] = row_rstd_lds(lr, ui, tok0 - u.pn * BM + e); r1[e] = row_rstd_lds(lr, ui, tok0 - u.pn * BM + 4 + e); }
            const int b = tok0 >> 12, ch = (tok0 >> 6) & 63, t = tok0 & 63;
#pragma unroll
            for (int ai = 0; ai < 2; ++ai)
#pragma unroll
                for (int m = 0; m < 4; ++m) {
                    const int f = f0 + ai * HALF + m * 16, h = f >> 6, d = f & 63;
                    const u32x4 w = pack8(acc[ai][bj][m][0] * r0, acc[ai][bj][m][1] * r1);
                    *(u32x4*)(VB + ((size_t)b * SLAB_E + (size_t)(h * 64 + ch) * 4096 + (t >> 4) * 1024 + (d >> 5) * 512 + ((t >> 3) & 1) * 256 + (d & 31) * 8)) = w;
                }
        }
    }
};
struct EpiRes {
    static constexpr bool PERM = true, AFTER_DRAIN = false;
    const bf16_t* base; float* out; bf16_t* XB; float* ssout; PG8_LAS float* red;     const float* ssq;
    __device__ __forceinline__ void prefetch(const Unit& u, int ui, int wid, int lane) const { if (ssq) rstd_prefetch(ssq, u.pm * BM, (PG8_LAS unsigned char*)red + 4096, ui, wid, lane); }
    __device__ __forceinline__ void operator()(const f32x4 (&acc)[2][2][4][2], const Unit& u, int wr, int wc, int fr, int fq, int ui) const {
        const int row0 = u.pm * BM + wr * 64 + fr;
#pragma unroll
        for (int ai = 0; ai < 2; ++ai)
#pragma unroll
            for (int m = 0; m < 4; ++m) {
                const int row = row0 + ai * HALF + m * 16; float s = 0.f;
                float r2 = 1.f; if (ssq) { const float r = row_rstd_lds((const PG8_LAS unsigned char*)red + 4096, ui, wr * 64 + fr + ai * HALF + m * 16); r2 = r * r; }
#pragma unroll
                for (int bj = 0; bj < 2; ++bj) {
                    const size_t off = (size_t)row * 1024 + (u.pn * BM + bj * HALF + wc * 32 + 8 * fq);
                    const u32x4 bw = *(const u32x4*)(base + off);
                    const f32x4 b0 = {__uint_as_float(bw.x << 16), __uint_as_float(bw.x & 0xffff0000u), __uint_as_float(bw.y << 16), __uint_as_float(bw.y & 0xffff0000u)};
                    const f32x4 b1 = {__uint_as_float(bw.z << 16), __uint_as_float(bw.z & 0xffff0000u), __uint_as_float(bw.w << 16), __uint_as_float(bw.w & 0xffff0000u)};
                    const f32x4 o0 = b0 + acc[ai][bj][m][0] * r2, o1 = b1 + acc[ai][bj][m][1] * r2;
                    if (out) { *(f32x4*)(out + off) = o0; *(f32x4*)(out + off + 4) = o1; }
                    if (XB) { *(u32x4*)(XB + off) = pack8(o0, o1); s += dot4(o0) + dot4(o1); }
                }
                if (!XB) continue;
                s += __shfl_xor(s, 16); s += __shfl_xor(s, 32);
                if (fq == 0) red[wc * 256 + ai * HALF + wr * 64 + m * 16 + fr] = s;
            }
        if (!XB) return;
        asm volatile("s_waitcnt lgkmcnt(0)" ::: "memory"); __builtin_amdgcn_s_barrier(); asm volatile("" ::: "memory");
        { const int t = (wr * 4 + wc) * 64 + fq * 16 + fr;
          if (t < 256) ssout[(size_t)(u.pm * BM + t) * 4 + u.pn] = (red[t] + red[256 + t]) + (red[512 + t] + red[768 + t]); }
    }
};
struct EpiRelu2 {
    static constexpr bool PERM = true, AFTER_DRAIN = false;
    bf16_t* H;
    __device__ __forceinline__ void prefetch(const Unit&, int, int, int) const {}
    __device__ __forceinline__ void operator()(const f32x4 (&acc)[2][2][4][2], const Unit& u, int wr, int wc, int fr, int fq, int) const {
        const int row0 = u.pm * BM + wr * 64 + fr;
#pragma unroll
        for (int ai = 0; ai < 2; ++ai)
#pragma unroll
            for (int m = 0; m < 4; ++m) {
                const int row = row0 + ai * HALF + m * 16;
#pragma unroll
                for (int bj = 0; bj < 2; ++bj) {
                    f32x4 v0 = acc[ai][bj][m][0], v1 = acc[ai][bj][m][1];
#pragma unroll
                    for (int e = 0; e < 4; ++e) { const float a = fmaxf(v0[e], 0.f), c = fmaxf(v1[e], 0.f); v0[e] = fmul_s(a, a); v1[e] = fmul_s(c, c); }
                    __builtin_nontemporal_store(pack8(v0, v1), (u32x4*)(H + (size_t)(row >> 12) * SLAB_E + (size_t)(row & 4095) * 4096 + (u.pn * BM + bj * HALF + wc * 32 + 8 * fq)));
                }
            }
    }
};

template <class Epi, class Sched, bool ALIGN_EPI = false, bool SP2 = false>
__device__ __forceinline__ void gemm_phase(PG8_LAS unsigned char* lds, const Gemm g, const Sched& S, const Epi& E, int ws) {
    const int tid = opaque_tid(ws), wid = __builtin_amdgcn_readfirstlane(tid >> 6), lane = tid & 63, wr = wid >> 2, wc = wid & 3, fr = lane & 15, fq = lane >> 4;
    const int K = g.K, nt = K / BK;
    unsigned voffA[2], voffB[2];
#pragma unroll
    for (int i = 0; i < 2; ++i) { int R, C; stage_rc(tid * 16 + i * 8192, R, C); const int Rb = Epi::PERM ? ((R & ~31) + perm32(R & 31)) : R;
        voffA[i] = (unsigned)(R * K + C) * 2u; voffB[i] = (unsigned)(Rb * K + C) * 2u; }
    const size_t kstep = (size_t)(BK * 2);
    const size_t hstep = (size_t)HALF * K * 2;
    const size_t tstep = 2 * hstep;
    const unsigned ldsw = (unsigned)wid * 1024u;
    const int aoff = lds_byte(wr * 64 + fr, fq * 8), boff = lds_byte(wc * 32 + fr, fq * 8);
#define PG8_SA(b, h) (((b) * 2 + (h)) * HTB)
#define PG8_SB(b, h) ((4 + (b) * 2 + (h)) * HTB)
#define PG8_STAGE(bufoff, gbase, voff) do { _Pragma("unroll") for (int _i = 0; _i < 2; ++_i) \
        __builtin_amdgcn_global_load_lds((const unsigned*)((const char*)(gbase) + (voff)[_i]), (PG8_LAS unsigned*)(lds + (bufoff) + ldsw + _i * 8192), 16, 0, 0); } while (0)
#define PG8_LDA(dst, b, h) do { _Pragma("unroll") for (int m = 0; m < 4; ++m) _Pragma("unroll") for (int k = 0; k < 2; ++k) dst[m][k] = *(const PG8_LAS bf16x8*)(lds + PG8_SA(b, h) + aoff + m * 2048 + k * 1024); } while (0)
#define PG8_LDB(dst, b, h) do { _Pragma("unroll") for (int n = 0; n < 2; ++n) _Pragma("unroll") for (int k = 0; k < 2; ++k) dst[n][k] = *(const PG8_LAS bf16x8*)(lds + PG8_SB(b, h) + boff + n * 2048 + k * 1024); } while (0)
#define PG8_MMA(ai, bj, At, Bt) do { __builtin_amdgcn_s_setprio(1); _Pragma("unroll") for (int m = 0; m < 4; ++m) _Pragma("unroll") for (int n = 0; n < 2; ++n) _Pragma("unroll") for (int k = 0; k < 2; ++k) \
        acc[ai][bj][m][n] = __builtin_amdgcn_mfma_f32_16x16x32_bf16(Bt[n][k], At[m][k], acc[ai][bj][m][n], 0, 0, 0); __builtin_amdgcn_s_setprio(0); } while (0)
#define PG8_WAIT_V(n) asm volatile("s_waitcnt vmcnt(" #n ")" ::: "memory")
#define PG8_WAIT_L(n) asm volatile("s_waitcnt lgkmcnt(" #n ")" ::: "memory")
#define PG8_BAR __builtin_amdgcn_s_barrier()
#define PG8_SCHED __builtin_amdgcn_sched_barrier(0)
    Unit cur, nxt; int ui = 0;
    if (!S.next(0, cur)) return;
    f32x4 acc[2][2][4][2];
#pragma unroll
    for (int a = 0; a < 2; ++a)
#pragma unroll
        for (int b = 0; b < 2; ++b)
#pragma unroll
            for (int m = 0; m < 4; ++m)
#pragma unroll
                for (int n = 0; n < 2; ++n) acc[a][b][m][n] = (f32x4){0.f, 0.f, 0.f, 0.f};
    bf16x8 At[4][2], B0[2][2], B1[2][2];
    const char* cA = (const char*)g.A + (size_t)(cur.pm >> 4) * g.a_bstride + (size_t)(cur.pm & 15) * tstep; const char* cB = (const char*)g.Bt + (size_t)cur.pn * tstep;
    S.a_ready(cur);
    E.prefetch(cur, 0, wid, lane);
    if constexpr (SP2) {
        PG8_STAGE(PG8_SB(0, 0), cB, voffB); PG8_STAGE(PG8_SB(0, 1), cB + hstep, voffB); PG8_STAGE(PG8_SA(0, 0), cA, voffA); PG8_STAGE(PG8_SA(0, 1), cA + hstep, voffA);
        if (wr == 1) PG8_BAR;
        PG8_WAIT_V(2); PG8_BAR;
        PG8_STAGE(PG8_SB(1, 0), cB + kstep, voffB); PG8_STAGE(PG8_SA(1, 0), cA + kstep, voffA); PG8_STAGE(PG8_SB(1, 1), cB + hstep + kstep, voffB);
        PG8_WAIT_V(6); PG8_BAR;
    } else {
        PG8_STAGE(PG8_SB(0, 0), cB, voffB); PG8_STAGE(PG8_SA(0, 0), cA, voffA); PG8_STAGE(PG8_SB(0, 1), cB + hstep, voffB); PG8_STAGE(PG8_SA(0, 1), cA + hstep, voffA);
        if (wr == 1) PG8_BAR;
        PG8_WAIT_V(4); PG8_BAR;
        PG8_STAGE(PG8_SB(1, 0), cB + kstep, voffB); PG8_STAGE(PG8_SA(1, 0), cA + kstep, voffA); PG8_STAGE(PG8_SB(1, 1), cB + hstep + kstep, voffB);
        PG8_WAIT_V(6); PG8_BAR;
    }
    for (;;) {
        const bool has_next = S.next(ui + 1, nxt);
        const char* nA = has_next ? (const char*)g.A + (size_t)(nxt.pm >> 4) * g.a_bstride + (size_t)(nxt.pm & 15) * tstep : cA; const char* nB = has_next ? (const char*)g.Bt + (size_t)nxt.pn * tstep : cB;
        asm volatile(".p2align 8" ::: "memory");
        for (int t = 0; t < nt; t += 2) {
            const bool last = (t == nt - 2);
            const char* a1 = cA + (size_t)(t + 1) * kstep;
            const char* a2 = last ? nA : cA + (size_t)(t + 2) * kstep; const char* b2 = last ? nB : cB + (size_t)(t + 2) * kstep;
            const char* a3 = a2 + kstep; const char* b3 = b2 + kstep;
            if (last && has_next) S.a_ready(nxt);
            if constexpr (SP2) {
            PG8_LDB(B0, 0, 0); PG8_LDB(B1, 0, 1); PG8_SCHED; PG8_LDA(At, 0, 0); PG8_STAGE(PG8_SA(1, 1), a1 + hstep, voffA);
            PG8_WAIT_V(8); PG8_WAIT_L(0); PG8_BAR; PG8_MMA(0, 0, At, B0); PG8_MMA(0, 1, At, B1); PG8_BAR; PG8_SCHED;
            PG8_LDA(At, 0, 1); PG8_STAGE(PG8_SB(0, 0), b2, voffB); PG8_STAGE(PG8_SB(0, 1), b2 + hstep, voffB); PG8_STAGE(PG8_SA(0, 0), a2, voffA);
            PG8_WAIT_V(8); PG8_WAIT_L(0); PG8_BAR; PG8_MMA(1, 0, At, B0); PG8_MMA(1, 1, At, B1); PG8_BAR; PG8_SCHED;
            PG8_LDB(B0, 1, 0); PG8_LDB(B1, 1, 1); PG8_SCHED; PG8_LDA(At, 1, 0); PG8_STAGE(PG8_SA(0, 1), a2 + hstep, voffA);
            PG8_WAIT_V(8); PG8_WAIT_L(0); PG8_BAR; PG8_MMA(0, 0, At, B0); PG8_MMA(0, 1, At, B1); PG8_BAR; PG8_SCHED;
            PG8_LDA(At, 1, 1); PG8_STAGE(PG8_SB(1, 0), b3, voffB); PG8_STAGE(PG8_SB(1, 1), b3 + hstep, voffB); PG8_STAGE(PG8_SA(1, 0), a3, voffA);
            PG8_WAIT_V(8); PG8_WAIT_L(0); PG8_BAR; PG8_MMA(1, 0, At, B0); PG8_MMA(1, 1, At, B1); PG8_BAR; PG8_SCHED;
            } else {
            PG8_LDB(B0, 0, 0); PG8_SCHED; PG8_LDA(At, 0, 0); PG8_STAGE(PG8_SA(1, 1), a1 + hstep, voffA);
            PG8_WAIT_L(8); PG8_BAR; PG8_WAIT_L(0); PG8_MMA(0, 0, At, B0); PG8_BAR; PG8_SCHED;
            PG8_LDB(B1, 0, 1); PG8_STAGE(PG8_SB(0, 0), b2, voffB);
            PG8_BAR; PG8_WAIT_L(0); PG8_MMA(0, 1, At, B1); PG8_BAR;
            PG8_LDA(At, 0, 1); PG8_STAGE(PG8_SA(0, 0), a2, voffA);
            PG8_BAR; PG8_WAIT_L(0); PG8_MMA(1, 0, At, B0); PG8_BAR; PG8_SCHED;
            PG8_STAGE(PG8_SB(0, 1), b2 + hstep, voffB);
            PG8_WAIT_V(6); PG8_BAR; PG8_MMA(1, 1, At, B1); PG8_BAR;
            PG8_LDB(B0, 1, 0); PG8_SCHED; PG8_LDA(At, 1, 0); PG8_STAGE(PG8_SA(0, 1), a2 + hstep, voffA);
            PG8_WAIT_L(8); PG8_BAR; PG8_WAIT_L(0); PG8_MMA(0, 0, At, B0); PG8_BAR; PG8_SCHED;
            PG8_LDB(B1, 1, 1); PG8_STAGE(PG8_SB(1, 0), b3, voffB);
            PG8_BAR; PG8_WAIT_L(0); PG8_MMA(0, 1, At, B1); PG8_BAR;
            PG8_LDA(At, 1, 1); PG8_STAGE(PG8_SA(1, 0), a3, voffA);
            PG8_BAR; PG8_WAIT_L(0); PG8_MMA(1, 0, At, B0); PG8_BAR; PG8_SCHED;
            PG8_STAGE(PG8_SB(1, 1), b3 + hstep, voffB);
            PG8_WAIT_V(6); PG8_BAR; PG8_MMA(1, 1, At, B1); PG8_BAR;
            }
        }
        if constexpr (ALIGN_EPI) { if (wr == 0) PG8_BAR; }
        if constexpr (!Epi::AFTER_DRAIN) { E(acc, cur, wr, wc, fr, fq, ui); S.done(cur); }
        if (!has_next) break;
#pragma unroll
        for (int a = 0; a < 2; ++a)
#pragma unroll
            for (int b = 0; b < 2; ++b)
#pragma unroll
                for (int m = 0; m < 4; ++m)
#pragma unroll
                    for (int n = 0; n < 2; ++n) acc[a][b][m][n] = (f32x4){0.f, 0.f, 0.f, 0.f};
        cur = nxt; cA = nA; cB = nB; ++ui;
        E.prefetch(cur, ui, wid, lane);
        if constexpr (ALIGN_EPI) { if (wr == 1) PG8_BAR; }
    }
    PG8_WAIT_V(0);
    if constexpr (!ALIGN_EPI) { if (wr == 0) PG8_BAR; }
    PG8_BAR;
#undef PG8_SA
#undef PG8_SB
#undef PG8_STAGE
#undef PG8_LDA
#undef PG8_LDB
#undef PG8_MMA
#undef PG8_WAIT_V
#undef PG8_WAIT_L
#undef PG8_BAR
#undef PG8_SCHED
}
}

constexpr int NWAVES = 8;
constexpr int DEPTH = 4, BATCH = 8, SEQ = 4096, D = 1024, M = BATCH * SEQ, DIN = 2560, FF = 4096, NH = 8;
constexpr int LDS_BYTES = 147456;
constexpr size_t MiB = 1u << 20;
constexpr size_t WS_SS = 416 * MiB, SS_BYTES = (size_t)9 * M * 4 * 4;
constexpr size_t WS_BAR = 1536 * 1024, BAR_BYTES = 32768;
constexpr int MISC_OFF = 131072 + 320;
constexpr size_t WS_W = 2 * MiB, W_LAYER = 23 * MiB;
constexpr size_t WO_MAIN = 0, WO_V = 4 * MiB, WO_OUT = 5 * MiB, WO_1 = 7 * MiB, WO_2 = 15 * MiB;
constexpr size_t WS_XB = 96 * MiB;
constexpr size_t WS_SLAB = 160 * MiB;
constexpr size_t WS_QB = WS_SLAB, WS_KB = WS_SLAB + 4 * MiB, WS_VB = WS_SLAB + 8 * MiB, WS_R = WS_SLAB + 12 * MiB, WS_MIX = WS_SLAB + 20 * MiB;
constexpr size_t WS_H = WS_SLAB;
constexpr size_t WS_END = 440 * MiB;
static_assert(WS_W + DEPTH * W_LAYER <= WS_XB && WS_SS + SS_BYTES <= WS_END, "ws map");

#define LAS __attribute__((address_space(3)))
typedef unsigned short bf16;
typedef unsigned v4u __attribute__((ext_vector_type(4)));
typedef unsigned v2u __attribute__((ext_vector_type(2)));
typedef float f32x4 __attribute__((ext_vector_type(4)));
typedef float f32x16 __attribute__((ext_vector_type(16)));
typedef short bf16x8 __attribute__((ext_vector_type(8)));
#define LDS_WAIT() asm volatile("s_waitcnt lgkmcnt(0)" ::: "memory")

__device__ __forceinline__ unsigned pk2(float lo, float hi) { return pg8::cvt_pk_bf16(lo, hi); }
__device__ __forceinline__ float bflo(unsigned w) { return __uint_as_float(w << 16); }
__device__ __forceinline__ float bfhi(unsigned w) { return __uint_as_float(w & 0xffff0000u); }
__device__ __forceinline__ float wave_sum(float v) {
#pragma unroll
    for (int o = 1; o < 64; o <<= 1) v += __shfl_xor(v, o);
    return v;
}

struct TrItem { const float* src; const float* gk; bf16* dst; int ldw, K; };
__device__ __forceinline__ void tr_load(const TrItem& it, f32x4 (&v)[8], int lane) {
    const int kr = lane >> 3, c4 = (lane & 7) * 4;
#pragma unroll
    for (int i = 0; i < 8; ++i) v[i] = *(const f32x4*)(it.src + (size_t)(8 * i + kr) * it.ldw + c4);
}
__device__ __forceinline__ void tr_finish(const TrItem& it, f32x4 (&v)[8], LAS float* scr, int lane) {
    const int kr = lane >> 3, c4 = (lane & 7) * 4;
    if (it.gk) {
#pragma unroll
        for (int i = 0; i < 8; ++i) v[i] = v[i] * it.gk[8 * i + kr];
    }
#pragma unroll
    for (int i = 0; i < 8; ++i) { LAS float* d = scr + (8 * i + kr) * 33 + c4; d[0] = v[i][0]; d[1] = v[i][1]; d[2] = v[i][2]; d[3] = v[i][3]; }
    LDS_WAIT(); asm volatile("" ::: "memory");
    const int c = lane & 7;
#pragma unroll
    for (int j = 0; j < 4; ++j) { const int n = (lane >> 3) + 8 * j; const LAS float* s = scr + (8 * c) * 33 + n;
        v4u o; o.x = pk2(s[0 * 33], s[1 * 33]); o.y = pk2(s[2 * 33], s[3 * 33]); o.z = pk2(s[4 * 33], s[5 * 33]); o.w = pk2(s[6 * 33], s[7 * 33]);
        *(v4u*)(it.dst + (size_t)n * it.K + 8 * c) = o; }
    LDS_WAIT(); asm volatile("" ::: "memory");
}

struct Args { const float* in[13]; float* out; unsigned char* ws; };

__device__ __forceinline__ void prologue(const Args& a, LAS unsigned char* lds, int ws) {
    const int tid = pg8::opaque_tid(ws), lane = tid & 63, wave = __builtin_amdgcn_readfirstlane(tid >> 6);
    LAS float* scr = (LAS float*)(lds + wave * 16384);
    const int gw = blockIdx.x * NWAVES + wave, NGW = gridDim.x * NWAVES;
    constexpr int PER_LAYER = 5760;
    auto decode = [&](int it) -> TrItem {
        const int l = it / PER_LAYER; int r = it % PER_LAYER;
        unsigned char* wl = a.ws + WS_W + (size_t)l * W_LAYER;
        TrItem t;
        if (r < 1024) {
            const int kb = r >> 6, db = r & 63, pn = db >> 3, jb = db & 7, bj = jb >> 2, wc = jb & 3;
            const int scol = pn < 4 ? (256 * pn + 64 * wc + 32 * bj) : (1536 + 256 * (pn - 4) + 32 * jb);
            t.src = a.in[2] + (size_t)l * D * DIN + (size_t)(64 * kb) * DIN + scol; t.ldw = DIN; t.gk = a.in[1] + l * D + 64 * kb; t.dst = (bf16*)(wl + WO_MAIN) + (size_t)(32 * db) * D + 64 * kb; t.K = D; return t; }
        r -= 1024;
        if (r < 256) { const int kb = r >> 4, db = r & 15;
            t.src = a.in[2] + (size_t)l * D * DIN + (size_t)(64 * kb) * DIN + 1024 + 32 * db; t.ldw = DIN; t.gk = a.in[1] + l * D + 64 * kb; t.dst = (bf16*)(wl + WO_V) + (size_t)(32 * db) * D + 64 * kb; t.K = D; return t; }
        r -= 256;
        if (r < 384) { const int kb = r >> 5, nb = r & 31;
            t.src = a.in[9] + (size_t)l * D * D + (size_t)(64 * kb) * D + 32 * nb; t.ldw = D; t.gk = nullptr; t.dst = (bf16*)(wl + WO_OUT) + (size_t)(32 * nb) * D + 64 * kb; t.K = D; return t; }
        r -= 384;
        if (r < 2048) { const int kb = r >> 7, nb = r & 127;
            t.src = a.in[11] + (size_t)l * D * FF + (size_t)(64 * kb) * FF + 32 * nb; t.ldw = FF; t.gk = a.in[10] + l * D + 64 * kb; t.dst = (bf16*)(wl + WO_1) + (size_t)(32 * nb) * D + 64 * kb; t.K = D; return t; }
        r -= 2048;
        { const int kb = r >> 5, nb = r & 31;
            t.src = a.in[12] + (size_t)l * FF * D + (size_t)(64 * kb) * D + 32 * nb; t.ldw = D; t.gk = nullptr; t.dst = (bf16*)(wl + WO_2) + (size_t)(32 * nb) * FF + 64 * kb; t.K = FF; return t; }
    };
    if (gw < DEPTH * PER_LAYER) {
        TrItem cur = decode(gw); f32x4 v[8]; tr_load(cur, v, lane);
        for (int it = gw; it < DEPTH * PER_LAYER; it += NGW) {
            const int nx = it + NGW;
            if (nx < DEPTH * PER_LAYER) { const TrItem nxt = decode(nx); f32x4 vn[8]; tr_load(nxt, vn, lane); tr_finish(cur, v, scr, lane); cur = nxt;
#pragma unroll
                for (int i = 0; i < 8; ++i) v[i] = vn[i]; }
            else tr_finish(cur, v, scr, lane);
        }
    }
    for (int it = blockIdx.x * (NWAVES * 64) + tid; it < DEPTH * 4 * 8 * 1024; it += gridDim.x * NWAVES * 64) {
        const int n = it & 1023, cc = (it >> 10) & 7, g = (it >> 13) & 3, l = it >> 15;
        const float* wo = a.in[9] + (size_t)l * D * D + (size_t)(768 + 64 * g) * D + n;
        const float* sc = a.in[8] + l * 256 + 64 * g;
        const float* pw = a.in[7] + ((size_t)(l * 4 + g) * 64 + 8 * cc) * 64;
        float acc[8];
#pragma unroll
        for (int j = 0; j < 8; ++j) acc[j] = 0.f;
        for (int d0 = 0; d0 < 64; d0 += 16) {
            float wv[16];
#pragma unroll
            for (int i = 0; i < 16; ++i) wv[i] = wo[(size_t)(d0 + i) * D];
#pragma unroll
            for (int i = 0; i < 16; ++i) { const float x = wv[i] * sc[d0 + i];
#pragma unroll
                for (int j = 0; j < 8; ++j) acc[j] += pw[j * 64 + d0 + i] * x; }
        }
        v4u o; o.x = pk2(acc[0], acc[1]); o.y = pk2(acc[2], acc[3]); o.z = pk2(acc[4], acc[5]); o.w = pk2(acc[6], acc[7]);
        *(v4u*)((bf16*)(a.ws + WS_W + (size_t)l * W_LAYER + WO_OUT) + (size_t)n * D + 768 + 64 * g + 8 * cc) = o;
    }
    bf16* XB = (bf16*)(a.ws + WS_XB); float* ss0 = (float*)(a.ws + WS_SS);
    {
        f32x4 v[4], w[4];
        { const f32x4* xr = (const f32x4*)(a.in[0] + (size_t)gw * D) + lane; const f32x4* xr2 = (const f32x4*)(a.in[0] + (size_t)(gw + NGW) * D) + lane;
#pragma unroll
          for (int j = 0; j < 4; ++j) { v[j] = xr[64 * j]; w[j] = xr2[64 * j]; } }
        for (int m = gw; m < M; m += 2 * NGW) {
            const int m2 = m + NGW, mn = m + 2 * NGW;
            f32x4 vn[4], wn[4];
            if (mn < M) { const f32x4* xr = (const f32x4*)(a.in[0] + (size_t)mn * D) + lane; const f32x4* xr2 = (const f32x4*)(a.in[0] + (size_t)(mn + NGW) * D) + lane;
#pragma unroll
                for (int j = 0; j < 4; ++j) { vn[j] = xr[64 * j]; wn[j] = xr2[64 * j]; } }
            float s = 0.f, s2 = 0.f;
            unsigned long long* o8 = (unsigned long long*)(XB + (size_t)m * D) + lane; unsigned long long* o82 = (unsigned long long*)(XB + (size_t)m2 * D) + lane;
#pragma unroll
            for (int j = 0; j < 4; ++j) { s += pg8::dot4(v[j]); o8[64 * j] = (unsigned long long)pk2(v[j][0], v[j][1]) | ((unsigned long long)pk2(v[j][2], v[j][3]) << 32);
                                          s2 += pg8::dot4(w[j]); o82[64 * j] = (unsigned long long)pk2(w[j][0], w[j][1]) | ((unsigned long long)pk2(w[j][2], w[j][3]) << 32); }
            s = wave_sum(s); s2 = wave_sum(s2);
            if (lane < 4) { ss0[(size_t)m * 4 + lane] = lane == 0 ? s : 0.f; ss0[(size_t)m2 * 4 + lane] = lane == 0 ? s2 : 0.f; }
            if (mn < M) {
#pragma unroll
                for (int j = 0; j < 4; ++j) { v[j] = vn[j]; w[j] = wn[j]; } }
        }
    }
}

struct Mode { int local, rank, xcc; };
__device__ __forceinline__ float max3f(float a, float b, float c) { return fmaxf(fmaxf(a, b), c); }
__device__ __forceinline__ float fadd_s(float a, float b) { float r; asm("v_add_f32_e32 %0, %1, %2" : "=v"(r) : "v"(a), "v"(b)); return r; }
__device__ __forceinline__ float swap32_max(float m) { auto rr = __builtin_amdgcn_permlane32_swap(__float_as_uint(m), __float_as_uint(m), false, false); return fmaxf(__uint_as_float(rr[0]), __uint_as_float(rr[1])); }
__device__ __forceinline__ float swap32_sum(float m) { auto rr = __builtin_amdgcn_permlane32_swap(__float_as_uint(m), __float_as_uint(m), false, false); return __uint_as_float(rr[0]) + __uint_as_float(rr[1]); }
typedef float f32x2_t __attribute__((ext_vector_type(2))); typedef __bf16 bf16x2_t __attribute__((ext_vector_type(2)));
__device__ __forceinline__ unsigned cvtpk_s(float lo, float hi) { f32x2_t v = {lo, hi}; bf16x2_t b = __builtin_convertvector(v, bf16x2_t); return __builtin_bit_cast(unsigned, b); }

__device__ __forceinline__ void attn_load_k(bf16x8 (&kf)[2][4], const bf16* kb, int lane) {
#pragma unroll
    for (int hf = 0; hf < 2; ++hf)
#pragma unroll
        for (int d0 = 0; d0 < 4; ++d0) kf[hf][d0] = *(const bf16x8*)(kb + d0 * 1024 + hf * 512 + lane * 8);
}
__device__ __forceinline__ void attn_load_v(bf16x8 (&vf)[2][4], const bf16* vb, int lane) {
#pragma unroll
    for (int dh = 0; dh < 2; ++dh)
#pragma unroll
        for (int s = 0; s < 4; ++s) vf[dh][s] = *(const bf16x8*)(vb + s * 1024 + dh * 512 + lane * 8);
}
__device__ __forceinline__ void attn_qk(const bf16x8 (&kf)[2][4], const bf16x8 (&qr)[4], f32x16& p0, f32x16& p1) {
    p0 = f32x16{}; p1 = f32x16{};
#pragma unroll
    for (int d0 = 0; d0 < 4; ++d0) { p0 = __builtin_amdgcn_mfma_f32_32x32x16_bf16(kf[0][d0], qr[d0], p0, 0, 0, 0); p1 = __builtin_amdgcn_mfma_f32_32x32x16_bf16(kf[1][d0], qr[d0], p1, 0, 0, 0); }
}
__device__ __forceinline__ void attn_softmax_pv(f32x16& p0, f32x16& p1, const bf16x8 (&vf)[2][4], int j, int qi, int hi, const LAS float* tb, float cb,
                                                float& mrun, float& l, f32x16& o0, f32x16& o1) {
    const float c0 = (j <= 5) ? cb : 0.f;
    if (j >= 6) {
        const LAS float* tq = tb + (qi + 64 * (8 - j) + 128 - 8 * hi - 55);
#pragma unroll
        for (int r = 0; r < 16; ++r) { const int key = (r >> 3) * 16 + (r & 7); p0[r] = fadd_s(p0[r], tq[55 - key]); p1[r] = fadd_s(p1[r], tq[55 - key - 32]); }
    }
    float rm = max3f(p0[0], p0[1], p1[0]);
#pragma unroll
    for (int r = 1; r < 16; ++r) rm = max3f(rm, p0[r], p1[r]);
    rm = fmaxf(rm, p0[0]); rm = swap32_max(rm);
    const float cand = rm + c0; const bool grow = cand > mrun + 8.f;
    const float mnew = grow ? cand : mrun, alpha = __builtin_amdgcn_exp2f(mrun - mnew); mrun = mnew;
    const float sub = mnew - c0;
    float rs0 = 0.f, rs1 = 0.f, rs2 = 0.f, rs3 = 0.f;
#pragma unroll
    for (int r = 0; r < 16; ++r) { p0[r] = __builtin_amdgcn_exp2f(p0[r] - sub); p1[r] = __builtin_amdgcn_exp2f(p1[r] - sub); }
#pragma unroll
    for (int r = 0; r < 16; r += 2) { rs0 = fadd_s(rs0, p0[r]); rs1 = fadd_s(rs1, p1[r]); rs2 = fadd_s(rs2, p0[r + 1]); rs3 = fadd_s(rs3, p1[r + 1]); }
    const float rsum = fadd_s(fadd_s(rs0, rs1), fadd_s(rs2, rs3));
    l = l * alpha + rsum;
    if (__builtin_amdgcn_ballot_w64(grow) != 0ull) {
#pragma unroll
        for (int r = 0; r < 16; ++r) { o0[r] *= alpha; o1[r] *= alpha; }
    }
    v4u pw[4];
#pragma unroll
    for (int s = 0; s < 2; ++s) {
        pw[s] = (v4u){cvtpk_s(p0[8 * s + 0], p0[8 * s + 1]), cvtpk_s(p0[8 * s + 2], p0[8 * s + 3]), cvtpk_s(p0[8 * s + 4], p0[8 * s + 5]), cvtpk_s(p0[8 * s + 6], p0[8 * s + 7])};
        pw[2 + s] = (v4u){cvtpk_s(p1[8 * s + 0], p1[8 * s + 1]), cvtpk_s(p1[8 * s + 2], p1[8 * s + 3]), cvtpk_s(p1[8 * s + 4], p1[8 * s + 5]), cvtpk_s(p1[8 * s + 6], p1[8 * s + 7])};
    }
#pragma unroll
    for (int s = 0; s < 4; ++s) { const bf16x8 pf = __builtin_bit_cast(bf16x8, pw[s]);
        o0 = __builtin_amdgcn_mfma_f32_32x32x16_bf16(vf[0][s], pf, o0, 0, 0, 0); o1 = __builtin_amdgcn_mfma_f32_32x32x16_bf16(vf[1][s], pf, o1, 0, 0, 0); }
}
__device__ __forceinline__ void attn_wave_unit64(int b, int h, int n, const bf16* QB, const bf16* KB, const bf16* VB, bf16* MIX, const LAS float* tab, LAS unsigned char* qslot, int lane_) {
    int lane = lane_; asm volatile("" : "+v"(lane));
    const int r32 = lane & 31, hi = lane >> 5;
    const size_t tok0 = (size_t)b * pg8::SLAB_E / 512 + n * 64 + r32;
#pragma unroll
    for (int hf = 0; hf < 2; ++hf)
#pragma unroll
        for (int d0 = 0; d0 < 4; ++d0) *(LAS bf16x8*)(qslot + (hf * 4 + d0) * 1024 + lane * 16) = *(const bf16x8*)(QB + (tok0 + hf * 32) * 512 + h * 64 + d0 * 16 + hi * 8);
    float mrunA = -1e30f, lA = 0.f, mrunB = -1e30f, lB = 0.f; f32x16 oA0 = f32x16{}, oA1 = f32x16{}, oB0 = f32x16{}, oB1 = f32x16{};
    const LAS float* tb = tab + h * 320;
    const float cb = tb[256];
    int j = (n < 8 ? 8 - n : 0);
    const bf16* kb = KB + (size_t)b * pg8::SLAB_E + (size_t)(h * 64 + (n + j - 8)) * 4096; const bf16* vb = VB + (size_t)b * pg8::SLAB_E + (size_t)(h * 64 + (n + j - 8)) * 4096;
    bf16x8 kf[2][4], vf[2][4]; f32x16 p0, p1; bf16x8 qr[4];
    attn_load_k(kf, kb, lane); attn_load_v(vf, vb, lane);
    for (;;) {
#pragma unroll
        for (int d0 = 0; d0 < 4; ++d0) qr[d0] = *(const LAS bf16x8*)(qslot + d0 * 1024 + lane * 16);
        attn_qk(kf, qr, p0, p1);
        attn_softmax_pv(p0, p1, vf, j, r32, hi, tb, cb, mrunA, lA, oA0, oA1);
#pragma unroll
        for (int d0 = 0; d0 < 4; ++d0) qr[d0] = *(const LAS bf16x8*)(qslot + (4 + d0) * 1024 + lane * 16);
        attn_qk(kf, qr, p0, p1);
        kb += 4096;
        if (j < 8) attn_load_k(kf, kb, lane);
        attn_softmax_pv(p0, p1, vf, j, 32 + r32, hi, tb, cb, mrunB, lB, oB0, oB1);
        if (j == 8) break;
        vb += 4096; attn_load_v(vf, vb, lane);
        ++j;
    }
    const float linvA = 1.f / swap32_sum(lA), linvB = 1.f / swap32_sum(lB);
    int lane2 = lane; asm volatile("" : "+v"(lane2));
    bf16* orow = MIX + (size_t)b * pg8::SLAB_E + (size_t)(n * 64 + (lane2 & 31)) * 1024 + h * 64 + 4 * (lane2 >> 5);
#pragma unroll
    for (int r4 = 0; r4 < 4; ++r4) {
        v2u w0, w1;
        w0.x = cvtpk_s(oA0[4 * r4] * linvA, oA0[4 * r4 + 1] * linvA); w0.y = cvtpk_s(oA0[4 * r4 + 2] * linvA, oA0[4 * r4 + 3] * linvA);
        w1.x = cvtpk_s(oA1[4 * r4] * linvA, oA1[4 * r4 + 1] * linvA); w1.y = cvtpk_s(oA1[4 * r4 + 2] * linvA, oA1[4 * r4 + 3] * linvA);
        *(v2u*)(orow + 8 * r4) = w0; *(v2u*)(orow + 32 + 8 * r4) = w1;
        w0.x = cvtpk_s(oB0[4 * r4] * linvB, oB0[4 * r4 + 1] * linvB); w0.y = cvtpk_s(oB0[4 * r4 + 2] * linvB, oB0[4 * r4 + 3] * linvB);
        w1.x = cvtpk_s(oB1[4 * r4] * linvB, oB1[4 * r4 + 1] * linvB); w1.y = cvtpk_s(oB1[4 * r4 + 2] * linvB, oB1[4 * r4 + 3] * linvB);
        *(v2u*)(orow + 32 * 1024 + 8 * r4) = w0; *(v2u*)(orow + 32 * 1024 + 32 + 8 * r4) = w1;
    }
}

__device__ __forceinline__ void unpack8(const v4u w, float (&f)[8]) { f[0] = bflo(w.x); f[1] = bfhi(w.x); f[2] = bflo(w.y); f[3] = bfhi(w.y); f[4] = bflo(w.z); f[5] = bfhi(w.z); f[6] = bflo(w.w); f[7] = bfhi(w.w); }

__device__ __forceinline__ void mixer_phase(const Args& a, int l, LAS unsigned char* lds, int ws, const Mode md) {
    const int tid = pg8::opaque_tid(ws), lane = tid & 63, wave = __builtin_amdgcn_readfirstlane(tid >> 6);
    const bf16* QB = (const bf16*)(a.ws + WS_QB); const bf16* KB = (const bf16*)(a.ws + WS_KB); const bf16* VB = (const bf16*)(a.ws + WS_VB);
    const bf16* Rall = (const bf16*)(a.ws + WS_R); bf16* MIXall = (bf16*)(a.ws + WS_MIX); bf16* MIX = MIXall;
    LAS float* tab = (LAS float*)lds;
    { const float* rb = a.in[5] + (size_t)l * NH * 257;
      for (int i = tid; i < NH * 320; i += NWAVES * 64) { const int h = i / 320, e = i % 320; tab[i] = rb[h * 257 + (e < 256 ? e : 256)] * 1.4426950408889634f; } }
    __syncthreads();
    const int gw = blockIdx.x * NWAVES + wave, NGW = gridDim.x * NWAVES;
    for (int stage = 0; stage < 2; ++stage) {
      if ((stage == 0) == (wave < 4)) {
        for (int k = 0; ; ++k) {
            const int blk = blockIdx.x;
            int bu;
            if (md.local) bu = k < 2 ? md.xcc * 64 + k * 32 + md.rank : 512;
            else if (gridDim.x == 256) { const int x = blk & 7, i = blk >> 3; bu = k < 2 ? ((k * 8 + x) * 4 + (i >> 3)) * 8 + (i & 7) : 512; }
            else bu = k * (int)gridDim.x + blk;
            if (bu >= BATCH * NH * 8) break;
            const int bh = bu >> 3, ng = bu & 7;
            attn_wave_unit64(bh >> 3, bh & 7, ng * 8 + wave, QB, KB, VB, MIX, tab, lds + 16384 + wave * 8192, lane);
        }
      } else {
        int tid2 = tid; asm volatile("" : "+v"(tid2));
        const int gt = md.local ? md.rank * (NWAVES * 64) + tid2 : blockIdx.x * (NWAVES * 64) + tid2, NGT = md.local ? 131072 : gridDim.x * NWAVES * 64;
        for (int it0 = gt; it0 < 131072; it0 += NGT) {
            const int it = md.local ? ((it0 >> 13) << 16) + ((md.xcc * 256 + ((it0 >> 5) & 255)) << 5) + (it0 & 31) : it0;
            const int type = it >> 16, vec = it & 31, run = (it & 65535) >> 5;
            const size_t tokg = (size_t)run * 16; const int tpos0 = (int)(tokg & (SEQ - 1)); const int c = vec * 8;
            const size_t tok0 = tpos0;
            const bf16* R = Rall + (tokg >> 12) * pg8::SLAB_E; bf16* MIX = MIXall + (tokg >> 12) * pg8::SLAB_E;
            if (type == 0) {
                const float* cw = a.in[6] + (size_t)l * 3 * 256 + c;
                float w0[8], w1[8], w2[8], zp2[8], zp1[8];
                { const f32x4 x0 = *(const f32x4*)(cw), x1 = *(const f32x4*)(cw + 4), y0 = *(const f32x4*)(cw + 256), y1 = *(const f32x4*)(cw + 260), z0 = *(const f32x4*)(cw + 512), z1 = *(const f32x4*)(cw + 516);
    #pragma unroll
                  for (int e = 0; e < 4; ++e) { w0[e] = x0[e]; w0[4 + e] = x1[e]; w1[e] = y0[e]; w1[4 + e] = y1[e]; w2[e] = z0[e]; w2[4 + e] = z1[e]; } }
                if (tpos0 >= 2) {
                    float g1[8], h1[8], g2[8], h2[8];
                    unpack8(*(const v4u*)(R + (tok0 - 2) * 1024 + 256 + c), g2); unpack8(*(const v4u*)(R + (tok0 - 2) * 1024 + 512 + c), h2);
                    unpack8(*(const v4u*)(R + (tok0 - 1) * 1024 + 256 + c), g1); unpack8(*(const v4u*)(R + (tok0 - 1) * 1024 + 512 + c), h1);
    #pragma unroll
                    for (int e = 0; e < 8; ++e) { zp2[e] = g2[e] * h2[e]; zp1[e] = g1[e] * h1[e]; }
                } else {
    #pragma unroll
                    for (int e = 0; e < 8; ++e) { zp2[e] = 0.f; zp1[e] = 0.f; }
                }
                for (int t4 = 0; t4 < 16; t4 += 4) {
                    v4u rgb[4], rgc[4], rhn[4];
    #pragma unroll
                    for (int t = 0; t < 4; ++t) { const bf16* rr = R + (tok0 + t4 + t) * 1024 + c; rgb[t] = *(const v4u*)(rr); rgc[t] = *(const v4u*)(rr + 256); rhn[t] = *(const v4u*)(rr + 512); }
    #pragma unroll
                    for (int t = 0; t < 4; ++t) {
                        float gb[8], gc[8], hn[8], y[8];
                        unpack8(rgb[t], gb); unpack8(rgc[t], gc); unpack8(rhn[t], hn);
    #pragma unroll
                        for (int e = 0; e < 8; ++e) { const float z = gc[e] * hn[e]; y[e] = gb[e] * (w0[e] * zp2[e] + w1[e] * zp1[e] + w2[e] * z); zp2[e] = zp1[e]; zp1[e] = z; }
                        v4u o; o.x = pk2(y[0], y[1]); o.y = pk2(y[2], y[3]); o.z = pk2(y[4], y[5]); o.w = pk2(y[6], y[7]);
                        *(v4u*)(MIX + (tok0 + t4 + t) * 1024 + 512 + c) = o;
                    }
                }
            } else {
                const int w = 2 << (vec >> 3);
                const bf16* ub = R + 768 + c;
                float S[8];
    #pragma unroll
                for (int e = 0; e < 8; ++e) S[e] = 0.f;
                if (tpos0 > 0) {
                    for (int j = 1; j < w; ++j) { float uu[8]; unpack8(*(const v4u*)(ub + (tok0 - j) * 1024), uu);
    #pragma unroll
                        for (int e = 0; e < 8; ++e) S[e] += uu[e]; }
                }
                for (int t4 = 0; t4 < 16; t4 += 4) {
                    v4u ru[4], ro[4];
    #pragma unroll
                    for (int t = 0; t < 4; ++t) { ru[t] = *(const v4u*)(ub + (tok0 + t4 + t) * 1024);
                        const int tpo = tpos0 + t4 + t - (w - 1);
                        ro[t] = *(const v4u*)(ub + (tok0 + t4 + t - (tpo >= 0 ? (w - 1) : 0)) * 1024); }
    #pragma unroll
                    for (int t = 0; t < 4; ++t) {
                        float ut[8], uo[8], mm[8]; unpack8(ru[t], ut); unpack8(ro[t], uo);
                        const int tp = tpos0 + t4 + t; const float rc = 1.f / (float)(tp + 1 < w ? tp + 1 : w);
                        const bool drop = tp - (w - 1) >= 0;
    #pragma unroll
                        for (int e = 0; e < 8; ++e) { S[e] += ut[e]; mm[e] = S[e] * rc - ut[e]; S[e] -= drop ? uo[e] : 0.f; }
                        v4u o; o.x = pk2(mm[0], mm[1]); o.y = pk2(mm[2], mm[3]); o.z = pk2(mm[4], mm[5]); o.w = pk2(mm[6], mm[7]);
                        *(v4u*)(MIX + (tok0 + t4 + t) * 1024 + 768 + c) = o;
                    }
                }
            }
        }
      }
    }
    __syncthreads();
}

#define XB_TMO      128
#define XB_XCNT(j)  (256  + 64 * (j))
#define XB_XSUB(j)  (1280 + 64 * (j))
#define XB_XGEN(j)  (2304 + 64 * (j))
#define XB_TOP      3328
#define XB_TOPGEN   3392
#define XCD_BAR_WORDS 3456
#define XB_SPIN_CAP (1u << 22)
__device__ __forceinline__ unsigned xb_ld(unsigned* p)              { return __hip_atomic_load(p, __ATOMIC_RELAXED, __HIP_MEMORY_SCOPE_AGENT); }
__device__ __forceinline__ unsigned xb_add(unsigned* p, unsigned v) { return __hip_atomic_fetch_add(p, v, __ATOMIC_RELAXED, __HIP_MEMORY_SCOPE_AGENT); }
__device__ __forceinline__ unsigned xb_xcc_id() { return (unsigned)__builtin_amdgcn_s_getreg((3 << 11) | 20) & 0xFu; }
#define XB_SPIN(cond, bar) do { unsigned _sp = 0; while (cond) { __builtin_amdgcn_s_sleep(1); \
    if ((++_sp & 255u) == 0u) { if (xb_ld(&(bar)[XB_TMO])) break; if (_sp > XB_SPIN_CAP) { atomicAdd(&(bar)[XB_TMO], 1u); break; } } } } while (0)
struct XcdBarrier { unsigned* bar; unsigned x; volatile LAS unsigned* st; };
__device__ __forceinline__ XcdBarrier xcd_barrier_post(unsigned* bar, volatile LAS unsigned* st) {
    XcdBarrier b; b.bar = bar; b.x = xb_xcc_id(); b.st = st;
    if (threadIdx.x == 0) st[4] = xb_add(&bar[XB_XCNT(b.x)], 1u);
    return b;
}
__device__ __forceinline__ void xcd_barrier_complete(unsigned* bar, unsigned x, unsigned& nloc, unsigned& nx) {
    const unsigned G = gridDim.x * gridDim.y * gridDim.z;
    unsigned sum, cnt, mine, sp = 0u;
    for (;;) {
        sum = 0u; cnt = 0u; mine = 0u;
#pragma unroll
        for (unsigned j = 0; j < 16; ++j) { const unsigned c = xb_ld(&bar[XB_XCNT(j)]); sum += c; cnt += (c > 0u) ? 1u : 0u; mine = (j == x) ? c : mine; }
        if (sum == G) break;
        __builtin_amdgcn_s_sleep(1);
        if ((++sp & 255u) == 0u) { if (xb_ld(&bar[XB_TMO])) break; if (sp > XB_SPIN_CAP) { atomicAdd(&bar[XB_TMO], 1u); break; } }
    }
    nloc = mine > 0u ? mine : 1u; nx = cnt > 0u ? cnt : 1u;
}
__device__ __forceinline__ void xcd_barrier(const XcdBarrier& b, int ws) {
    asm volatile("s_waitcnt vmcnt(0)" ::: "memory");
    __syncthreads();
    if (ws == 0 && pg8::lane_id() == 0) {
        unsigned* bar = b.bar;
        __builtin_amdgcn_s_waitcnt(0);
        unsigned nloc = b.st[0], nx = b.st[1];
        if (nloc == 0u) { xcd_barrier_complete(bar, b.x, nloc, nx); b.st[0] = nloc; b.st[1] = nx; }
        const unsigned old = xb_add(&bar[XB_XSUB(b.x)], 1u);
        const unsigned gen = old / nloc;
        if (old + 1u == (gen + 1u) * nloc) {
            __builtin_amdgcn_fence(__ATOMIC_RELEASE, "agent");
            asm volatile("s_waitcnt vmcnt(0)" ::: "memory");
            const unsigned og = xb_add(&bar[XB_TOP], 1u);
            const unsigned tg = og / nx;
            if (og + 1u == (tg + 1u) * nx) xb_add(&bar[XB_TOPGEN], 1u);
            else XB_SPIN(xb_ld(&bar[XB_TOPGEN]) == tg, bar);
            __builtin_amdgcn_fence(__ATOMIC_ACQUIRE, "agent");
            xb_add(&bar[XB_XGEN(b.x)], 1u);
            asm volatile("s_waitcnt vmcnt(0)" ::: "memory");
        } else {
            XB_SPIN(xb_ld(&bar[XB_XGEN(b.x)]) == gen, bar);
            __builtin_amdgcn_fence(__ATOMIC_ACQUIRE, "agent");
            asm volatile("s_waitcnt vmcnt(0)" ::: "memory");
        }
    }
    __syncthreads();
}
#define XB_LSUB(j)  (3456 + 64 * (j))
#define XB_LGEN(j)  (4480 + 64 * (j))
__device__ __forceinline__ void xcd_local_barrier(unsigned* bar, unsigned x, int ws) {
    asm volatile("s_waitcnt vmcnt(0)" ::: "memory");
    __syncthreads();
    if (ws == 0 && pg8::lane_id() == 0) {
        const unsigned old = xb_add(&bar[XB_LSUB(x)], 1u);
        const unsigned gen = old / 32u;
        if (old + 1u == (gen + 1u) * 32u) xb_add(&bar[XB_LGEN(x)], 1u);
        else XB_SPIN(xb_ld(&bar[XB_LGEN(x)]) == gen, bar);
        __builtin_amdgcn_fence(__ATOMIC_ACQUIRE, "agent");
        asm volatile("s_waitcnt vmcnt(0)" ::: "memory");
    }
    __syncthreads();
}
__device__ __forceinline__ Mode get_mode(LAS unsigned char* lds) {
    volatile LAS unsigned* MI = (volatile LAS unsigned*)(lds + MISC_OFF);
    Mode m; m.local = __builtin_amdgcn_readfirstlane((int)MI[13]); m.rank = __builtin_amdgcn_readfirstlane((int)MI[12]); m.xcc = (int)xb_xcc_id(); return m;
}
#define gsync(grid) do { const Mode m_ = get_mode(lds); if (m_.local) xcd_local_barrier((unsigned*)(a.ws + WS_BAR), (unsigned)m_.xcc, ws); \
    else { XcdBarrier b_; b_.bar = (unsigned*)(a.ws + WS_BAR); b_.x = xb_xcc_id(); b_.st = (volatile LAS unsigned*)(lds + MISC_OFF) + 8; xcd_barrier(b_, ws); } } while (0)
__global__ void __launch_bounds__(NWAVES * 64, 2) fwd_megakernel(Args a) {
    extern __shared__ __attribute__((aligned(16))) unsigned char lds_raw[];
    LAS unsigned char* lds = (LAS unsigned char*)lds_raw;
    cg::grid_group grid = cg::this_grid();
    int ws = __builtin_amdgcn_readfirstlane(threadIdx.x >> 6); asm volatile("" : "+s"(ws));
    const int G = gridDim.x;
    unsigned char* wsp = a.ws;

    volatile LAS unsigned* MISC = (volatile LAS unsigned*)(lds + MISC_OFF);
    if (threadIdx.x < 32) MISC[threadIdx.x] = 0u;
    __syncthreads();
    (void)xcd_barrier_post((unsigned*)(wsp + WS_BAR), MISC + 8);
    if (a.ws == nullptr) grid.sync();
    prologue(a, lds, ws);
    gsync(grid);
    if (threadIdx.x == 0) {
        unsigned* bar = (unsigned*)(wsp + WS_BAR); unsigned ok = gridDim.x == 256 ? 1u : 0u;
        for (unsigned j = 0; j < 16; ++j) { const unsigned c = xb_ld(&bar[XB_XCNT(j)]); ok &= (j < 8 ? c == 32u : c == 0u) ? 1u : 0u; }
        MISC[13] = ok;
    }
    __syncthreads();

    for (int l = 0; l < DEPTH; ++l) {
        unsigned char* wsl = a.ws; asm volatile("" : "+s"(wsl));
        float* ss = (float*)(wsl + WS_SS);
        bf16* XB = (bf16*)(wsl + WS_XB); bf16* QB = (bf16*)(wsl + WS_QB); bf16* KB = (bf16*)(wsl + WS_KB); bf16* VB = (bf16*)(wsl + WS_VB);
        bf16* R = (bf16*)(wsl + WS_R); bf16* MIX = (bf16*)(wsl + WS_MIX); bf16* HB = (bf16*)(wsl + WS_H);
        unsigned char* wl = wsl + WS_W + (size_t)l * W_LAYER;
        const float* ss1 = ss + (size_t)(2 * l) * M * 4; float* ss2 = ss + (size_t)(2 * l + 1) * M * 4; float* ss3 = ss + (size_t)(2 * l + 2) * M * 4;
        {
            pg8::Gemm g{XB, (const bf16*)(wl + WO_MAIN), M, 2048, D, (size_t)SEQ * D * 2}; const Mode md = get_mode(lds); pg8::StaticOrder S; S.init(md.local ? 16 : 128, 8, md.local ? 32 : G, md.local ? md.rank : (int)blockIdx.x, !md.local, md.local ? 16 * md.xcc : 0, 0);
            PG8_LAS unsigned char* lr = lds + 131072 + 1024 + 4096;
            { const int t = pg8::opaque_tid(ws); if (t < 128) ((PG8_LAS float*)(lr + 8192))[t] = (t < 64 ? a.in[3] + l * 64 : a.in[4] + l * 64 - 64)[t]; }
            __syncthreads();
            pg8::EpiIn E{ss1, QB, KB, R, lr};
            pg8::gemm_phase<pg8::EpiIn, pg8::StaticOrder, true, true>(lds, g, S, E, ws);
            pg8::Gemm g2{(const bf16*)(wl + WO_V), XB, 512, M, D, 0}; pg8::StaticOrder S2; S2.init(2, md.local ? 16 : 128, md.local ? 32 : G, md.local ? md.rank : (int)blockIdx.x, !md.local, 0, md.local ? 16 * md.xcc : 0);
            pg8::EpiVT E2{ss1, VB, lr};
            pg8::gemm_phase<pg8::EpiVT, pg8::StaticOrder, true, true>(lds, g2, S2, E2, ws);
        }
        gsync(grid);
        mixer_phase(a, l, lds, ws, get_mode(lds));
        gsync(grid);
        {
            pg8::Gemm g{MIX, (const bf16*)(wl + WO_OUT), M, D, D, pg8::SLAB_E * 2}; const Mode md = get_mode(lds); pg8::StaticOrder S; S.init(md.local ? 16 : 128, 4, md.local ? 32 : G, md.local ? md.rank : (int)blockIdx.x, !md.local, md.local ? 16 * md.xcc : 0, 0);
            pg8::EpiRes E{XB, nullptr, XB, ss2, (PG8_LAS float*)(lds + 131072 + 1024), nullptr};
            pg8::gemm_phase<pg8::EpiRes, pg8::StaticOrder, true, true>(lds, g, S, E, ws);
        }
        gsync(grid);
        {
            pg8::Gemm g{XB, (const bf16*)(wl + WO_1), M, FF, D, (size_t)SEQ * D * 2}; const Mode md = get_mode(lds); pg8::StaticOrder S; S.init(md.local ? 16 : 128, 16, md.local ? 32 : G, md.local ? md.rank : (int)blockIdx.x, !md.local, md.local ? 16 * md.xcc : 0, 0);
            pg8::EpiRelu2 E{HB};
            pg8::gemm_phase<pg8::EpiRelu2, pg8::StaticOrder, true, true>(lds, g, S, E, ws);
        }
        gsync(grid);
        {
            pg8::Gemm g{HB, (const bf16*)(wl + WO_2), M, D, FF, pg8::SLAB_E * 2}; const Mode md = get_mode(lds); pg8::StaticOrder S; S.init(md.local ? 16 : 128, 4, md.local ? 32 : G, md.local ? md.rank : (int)blockIdx.x, !md.local, md.local ? 16 * md.xcc : 0, 0);
            pg8::EpiRes E{XB, l + 1 < DEPTH ? nullptr : a.out, l + 1 < DEPTH ? XB : nullptr, ss3, (PG8_LAS float*)(lds + 131072 + 1024), ss2};
            pg8::gemm_phase<pg8::EpiRes, pg8::StaticOrder, true, true>(lds, g, S, E, ws);
        }
        if (l + 1 < DEPTH) gsync(grid);
    }
}

extern "C" void kernel_launch(void* const* d_in, const int* in_sizes, int n_in, void* d_out, int out_size, void* d_ws, size_t ws_size, hipStream_t stream) {
    static int grid = 0;
    if (grid == 0) {
        if (n_in != 13 || in_sizes[0] != M * D || out_size != M * D || ws_size < WS_END) { fprintf(stderr, "kernel_launch: unexpected shapes (n_in %d, in0 %d, out %d, ws %zu)\n", n_in, n_in > 0 ? in_sizes[0] : -1, out_size, ws_size); grid = -1; return; }
        int dev = 0, cus = 0, per_cu = 0;
        (void)hipGetDevice(&dev); (void)hipDeviceGetAttribute(&cus, hipDeviceAttributeMultiprocessorCount, dev);
        if (hipFuncSetAttribute((const void*)fwd_megakernel, hipFuncAttributeMaxDynamicSharedMemorySize, LDS_BYTES) != hipSuccess) { fprintf(stderr, "kernel_launch: hipFuncSetAttribute failed\n"); grid = -1; return; }
        if (hipOccupancyMaxActiveBlocksPerMultiprocessor(&per_cu, (const void*)fwd_megakernel, NWAVES * 64, LDS_BYTES) != hipSuccess || per_cu < 1) { fprintf(stderr, "kernel_launch: occupancy query says %d\n", per_cu); per_cu = 1; }
        (void)hipGetLastError();
        grid = cus;
    }
    if (grid < 0) return;
    (void)hipMemsetAsync((char*)d_ws + WS_BAR, 0, BAR_BYTES, stream);
    Args a{};
    for (int i = 0; i < 13; ++i) a.in[i] = (const float*)d_in[i];
    a.out = (float*)d_out; a.ws = (unsigned char*)d_ws;
    void* args[] = {&a};
    hipError_t e = hipLaunchCooperativeKernel((const void*)fwd_megakernel, dim3(grid), dim3(NWAVES * 64), args, LDS_BYTES, stream);
    if (e != hipSuccess) fprintf(stderr, "cooperative launch failed: %s (grid %d)\n", hipGetErrorString(e), grid);
}
```

```cpp
#include <hip/hip_runtime.h>
#include <hip/hip_cooperative_groups.h>
#include <cstdio>
#include <cstdint>
namespace cg = cooperative_groups;

namespace pg8 {
#define PG8_LAS __attribute__((address_space(3)))
typedef unsigned short bf16_t;
typedef short bf16x8 __attribute__((ext_vector_type(8)));
typedef float f32x4 __attribute__((ext_vector_type(4)));
typedef unsigned u32x4 __attribute__((ext_vector_type(4)));
typedef unsigned u32x2 __attribute__((ext_vector_type(2)));
constexpr int BM = 256, BK = 64, HALF = 128, HTB = HALF * BK * 2  , STAGE_BYTES = 8 * HTB, NXCD = 8, WGM = 8;

__host__ __device__ __forceinline__ int lds_byte(int r, int c) { const int st = (r >> 4) * 2 + (c >> 5), rr = r & 15, cc = c & 31, ob = rr * 64 + cc * 2; return st * 1024 + (ob ^ (((ob >> 9) & 1) << 5)); }
__host__ __device__ __forceinline__ void stage_rc(int b, int& R, int& C) { const int st = b / 1024, sb = b % 1024, swz = sb ^ (((sb >> 9) & 1) << 5); R = (st >> 1) * 16 + swz / 64; C = (st & 1) * 32 + (swz % 64) / 2; }
__host__ __device__ __forceinline__ int perm32(int rho) { const int n = rho >> 4, i = rho & 15; return 8 * (i >> 2) + 4 * n + (i & 3); }

struct Unit { int pm, pn; };
struct Gemm { const bf16_t* A; const bf16_t* Bt; int M, N, K; size_t a_bstride; };

struct StaticOrder {
    int nM, nN, nwg, G, c, remap, pmo, pno;
    __host__ __device__ void init(int nM_, int nN_, int G_, int c_, int remap_, int pmo_, int pno_) { nM = nM_; nN = nN_; nwg = nM * nN; G = G_; c = c_; remap = remap_; pmo = pmo_; pno = pno_; }
    __host__ __device__ bool next(int i, Unit& u) const {
        const long L = (long)i * G + c; if (L >= nwg) return false;
        int wgid = (int)L; if (remap) { const int q = nwg / NXCD, r = nwg % NXCD, xcd = wgid % NXCD, off = wgid / NXCD; wgid = (xcd < r ? xcd * (q + 1) : r * (q + 1) + (xcd - r) * q) + off; }
        const int nig = WGM * nN, gid = wgid / nig, fm = gid * WGM, gsz = (nM - fm) < WGM ? (nM - fm) : WGM;
        u.pm = pmo + fm + ((wgid % nig) % gsz); u.pn = pno + (wgid % nig) / gsz; return true;
    }
    __device__ __forceinline__ void a_ready(const Unit&) const {}
    __device__ __forceinline__ void done(const Unit&) const {}
};

__device__ __forceinline__ int lane_id() { int l; asm volatile("v_mbcnt_lo_u32_b32 %0, -1, 0\n\tv_mbcnt_hi_u32_b32 %0, -1, %0" : "=v"(l)); return l; }
__device__ __forceinline__ int opaque_tid(int ws) { return ws * 64 + lane_id(); }
__device__ __forceinline__ unsigned cvt_pk_bf16(float lo, float hi) { unsigned r; asm volatile("v_cvt_pk_bf16_f32 %0, %1, %2" : "=v"(r) : "v"(lo), "v"(hi)); return r; }
__device__ __forceinline__ u32x4 pack8(const f32x4& v0, const f32x4& v1) { u32x4 w; w.x = cvt_pk_bf16(v0[0], v0[1]); w.y = cvt_pk_bf16(v0[2], v0[3]); w.z = cvt_pk_bf16(v1[0], v1[1]); w.w = cvt_pk_bf16(v1[2], v1[3]); return w; }
__device__ __forceinline__ float fmul_s(float a, float b) { float r; asm("v_mul_f32_e32 %0, %1, %2" : "=v"(r) : "v"(a), "v"(b)); return r; }
__device__ __forceinline__ float fq_sum(float s) {
    auto a = __builtin_amdgcn_permlane16_swap(__float_as_uint(s), __float_as_uint(s), false, false); s = __uint_as_float(a[0]) + __uint_as_float(a[1]);
    auto b = __builtin_amdgcn_permlane32_swap(__float_as_uint(s), __float_as_uint(s), false, false); return __uint_as_float(b[0]) + __uint_as_float(b[1]);
}
__device__ __forceinline__ float dot4(const f32x4& v) { return (v[0] * v[0] + v[1] * v[1]) + (v[2] * v[2] + v[3] * v[3]); }

constexpr float EPS = 1e-6f;
constexpr size_t SLAB_E = (size_t)16 << 20;

__device__ __forceinline__ float row_rstd(const float* ssp, int row) {
    const f32x4 a = *(const f32x4*)(ssp + (size_t)row * 4);
    const float s = (a[0] + a[1]) + (a[2] + a[3]);
    return rsqrtf(s * (1.f / 1024.f) + EPS);
}

__device__ __forceinline__ void rstd_prefetch(const float* ssp, int row0, PG8_LAS unsigned char* lr, int ui, int wid, int lane) {
    if (wid < 4) __builtin_amdgcn_global_load_lds((const unsigned*)(ssp + (size_t)(row0 + wid * 64 + lane) * 4), (PG8_LAS unsigned*)(lr + (ui & 1) * 4096 + wid * 1024), 16, 0, 0);
}
__device__ __forceinline__ float row_rstd_lds(const PG8_LAS unsigned char* lr, int ui, int r) {
    const f32x4 a = *(const PG8_LAS f32x4*)(lr + (ui & 1) * 4096 + r * 16);
    const float s = (a[0] + a[1]) + (a[2] + a[3]);
    return rsqrtf(s * (1.f / 1024.f) + EPS);
}
constexpr float QSCALE = 0.125f * 1.4426950408889634f;

struct EpiIn {
    static constexpr bool PERM = true, AFTER_DRAIN = false;
    const float* ss; bf16_t* QB; bf16_t* KB; bf16_t* R; PG8_LAS unsigned char* lr;
    __device__ __forceinline__ void prefetch(const Unit& u, int ui, int wid, int lane) const { rstd_prefetch(ss, u.pm * BM, lr, ui, wid, lane); }
    __device__ __forceinline__ void operator()(const f32x4 (&acc)[2][2][4][2], const Unit& u, int wr, int wc, int fr, int fq, int ui) const {
        const int row0 = u.pm * BM + wr * 64 + fr, rl0 = wr * 64 + fr;
        if (u.pn < 4) {
            const bool isq = u.pn < 2;
            const PG8_LAS float* gp = (const PG8_LAS float*)(lr + 8192) + (isq ? 0 : 64);
            f32x4 gv[2][2];
#pragma unroll
            for (int bj = 0; bj < 2; ++bj)
#pragma unroll
                for (int n = 0; n < 2; ++n) gv[bj][n] = *(const PG8_LAS f32x4*)(gp + 32 * bj + 8 * fq + 4 * n);
            const float post = isq ? QSCALE : 1.f;
#pragma unroll
            for (int ai = 0; ai < 2; ++ai)
#pragma unroll
                for (int m = 0; m < 4; ++m) {
                    const int row = row0 + ai * HALF + m * 16;
                    const float rs = row_rstd_lds(lr, ui, rl0 + ai * HALF + m * 16);
                    f32x4 v[2][2]; float s = 0.f;
#pragma unroll
                    for (int bj = 0; bj < 2; ++bj)
#pragma unroll
                        for (int n = 0; n < 2; ++n) { v[bj][n] = acc[ai][bj][m][n] * rs; s += dot4(v[bj][n]); }
                    s = fq_sum(s);
                    const float hr = rsqrtf(s * (1.f / 64.f) + EPS) * post;
#pragma unroll
                    for (int bj = 0; bj < 2; ++bj) {
                        const f32x4 v0 = v[bj][0] * hr * gv[bj][0], v1 = v[bj][1] * hr * gv[bj][1];
                        const u32x4 w = pack8(v0, v1);
                        if (isq) { *(u32x4*)(QB + (size_t)(row >> 12) * SLAB_E + (size_t)(row & 4095) * 512 + (u.pn * 256 + 64 * wc + 32 * bj + 8 * fq)) = w; }
                        else {
                            const int h = (u.pn - 2) * 4 + wc, b = row >> 12, ch = (row >> 6) & 63, key = row & 63, dcol = 32 * bj + 8 * fq;
                            const int k5 = key & 31, rho = (k5 & 19) | ((k5 & 4) << 1) | ((k5 & 8) >> 1);
                            *(u32x4*)(KB + ((size_t)b * SLAB_E + (size_t)(h * 64 + ch) * 4096 + (dcol >> 4) * 1024 + (key >> 5) * 512 + ((dcol >> 3) & 1) * 256 + rho * 8)) = w;
                        }
                    }
                }
        } else {
#pragma unroll
            for (int ai = 0; ai < 2; ++ai)
#pragma unroll
                for (int m = 0; m < 4; ++m) {
                    const int row = row0 + ai * HALF + m * 16;
                    const float rs = row_rstd_lds(lr, ui, rl0 + ai * HALF + m * 16);
#pragma unroll
                    for (int bj = 0; bj < 2; ++bj) {
                        const u32x4 w = pack8(acc[ai][bj][m][0] * rs, acc[ai][bj][m][1] * rs);
                        *(u32x4*)(R + (size_t)(row >> 12) * SLAB_E + (size_t)(row & 4095) * 1024 + ((u.pn - 4) * 256 + bj * HALF + wc * 32 + 8 * fq)) = w;
                    }
                }
        }
    }
};
struct EpiVT {
    static constexpr bool PERM = true, AFTER_DRAIN = false;
    const float* ss; bf16_t* VB; PG8_LAS unsigned char* lr;
    __device__ __forceinline__ void prefetch(const Unit& u, int ui, int wid, int lane) const { rstd_prefetch(ss, u.pn * BM, lr, ui, wid, lane); }
    __device__ __forceinline__ void operator()(const f32x4 (&acc)[2][2][4][2], const Unit& u, int wr, int wc, int fr, int fq, int ui) const {
        const int f0 = u.pm * BM + wr * 64 + fr;
#pragma unroll
        for (int bj = 0; bj < 2; ++bj) {
            const int tok0 = u.pn * BM + bj * HALF + wc * 32 + 8 * fq;
            f32x4 r0, r1;
#pragma unroll
            for (int e = 0; e < 4; ++e) { r0[e] = row_rstd_lds(lr, ui, tok0 - u.pn * BM + e); r1[e] = row_rstd_lds(lr, ui, tok0 - u.pn * BM + 4 + e); }
            const int b = tok0 >> 12, ch = (tok0 >> 6) & 63, t = tok0 & 63;
#pragma unroll
            for (int ai = 0; ai < 2; ++ai)
#pragma unroll
                for (int m = 0; m < 4; ++m) {
                    const int f = f0 + ai * HALF + m * 16, h = f >> 6, d = f & 63;
                    const u32x4 w = pack8(acc[ai][bj][m][0] * r0, acc[ai][bj][m][1] * r1);
                    *(u32x4*)(VB + ((size_t)b * SLAB_E + (size_t)(h * 64 + ch) * 4096 + (t >> 4) * 1024 + (d >> 5) * 512 + ((t >> 3) & 1) * 256 + (d & 31) * 8)) = w;
                }
        }
    }
};
struct EpiRes {
    static constexpr bool PERM = true, AFTER_DRAIN = false;
    const bf16_t* base; float* out; bf16_t* XB; float* ssout; PG8_LAS float* red;     const float* ssq;
    __device__ __forceinline__ void prefetch(const Unit& u, int ui, int wid, int lane) const { if (ssq) rstd_prefetch(ssq, u.pm * BM, (PG8_LAS unsigned char*)red + 4096, ui, wid, lane); }
    __device__ __forceinline__ void operator()(const f32x4 (&acc)[2][2][4][2], const Unit& u, int wr, int wc, int fr, int fq, int ui) const {
        const int row0 = u.pm * BM + wr * 64 + fr;
#pragma unroll
        for (int ai = 0; ai < 2; ++ai)
#pragma unroll
            for (int m = 0; m < 4; ++m) {
                const int row = row0 + ai * HALF + m * 16; float s = 0.f;
                float r2 = 1.f; if (ssq) { const float r = row_rstd_lds((const PG8_LAS unsigned char*)red + 4096, ui, wr * 64 + fr + ai * HALF + m * 16); r2 = r * r; }
#pragma unroll
                for (int bj = 0; bj < 2; ++bj) {
                    const size_t off = (size_t)row * 1024 + (u.pn * BM + bj * HALF + wc * 32 + 8 * fq);
                    const u32x4 bw = *(const u32x4*)(base + off);
                    const f32x4 b0 = {__uint_as_float(bw.x << 16), __uint_as_float(bw.x & 0xffff0000u), __uint_as_float(bw.y << 16), __uint_as_float(bw.y & 0xffff0000u)};
                    const f32x4 b1 = {__uint_as_float(bw.z << 16), __uint_as_float(bw.z & 0xffff0000u), __uint_as_float(bw.w << 16), __uint_as_float(bw.w & 0xffff0000u)};
                    const f32x4 o0 = b0 + acc[ai][bj][m][0] * r2, o1 = b1 + acc[ai][bj][m][1] * r2;
                    if (out) { *(f32x4*)(out + off) = o0; *(f32x4*)(out + off + 4) = o1; }
                    if (XB) { *(u32x4*)(XB + off) = pack8(o0, o1); s += dot4(o0) + dot4(o1); }
                }
                if (!XB) continue;
                s = fq_sum(s);
                if (fq == 0) red[wc * 256 + ai * HALF + wr * 64 + m * 16 + fr] = s;
            }
        if (!XB) return;
        asm volatile("s_waitcnt lgkmcnt(0)" ::: "memory"); __builtin_amdgcn_s_barrier(); asm volatile("" ::: "memory");
        { const int t = (wr * 4 + wc) * 64 + fq * 16 + fr;
          if (t < 256) ssout[(size_t)(u.pm * BM + t) * 4 + u.pn] = (red[t] + red[256 + t]) + (red[512 + t] + red[768 + t]); }
    }
};
struct EpiRelu2 {
    static constexpr bool PERM = true, AFTER_DRAIN = false;
    bf16_t* H;
    __device__ __forceinline__ void prefetch(const Unit&, int, int, int) const {}
    __device__ __forceinline__ void operator()(const f32x4 (&acc)[2][2][4][2], const Unit& u, int wr, int wc, int fr, int fq, int) const {
        const int row0 = u.pm * BM + wr * 64 + fr;
#pragma unroll
        for (int ai = 0; ai < 2; ++ai)
#pragma unroll
            for (int m = 0; m < 4; ++m) {
                const int row = row0 + ai * HALF + m * 16;
#pragma unroll
                for (int bj = 0; bj < 2; ++bj) {
                    f32x4 v0 = acc[ai][bj][m][0], v1 = acc[ai][bj][m][1];
#pragma unroll
                    for (int e = 0; e < 4; ++e) { const float a = fmaxf(v0[e], 0.f), c = fmaxf(v1[e], 0.f); v0[e] = fmul_s(a, a); v1[e] = fmul_s(c, c); }
                    __builtin_nontemporal_store(pack8(v0, v1), (u32x4*)(H + (size_t)(row >> 12) * SLAB_E + (size_t)(row & 4095) * 4096 + (u.pn * BM + bj * HALF + wc * 32 + 8 * fq)));
                }
            }
    }
};

template <class Epi, class Sched, bool ALIGN_EPI = false, bool SP2 = false>
__device__ __forceinline__ void gemm_phase(PG8_LAS unsigned char* lds, const Gemm g, const Sched& S, const Epi& E, int ws) {
    const int tid = opaque_tid(ws), wid = __builtin_amdgcn_readfirstlane(tid >> 6), lane = tid & 63, wr = wid >> 2, wc = wid & 3, fr = lane & 15, fq = lane >> 4;
    const int K = g.K, nt = K / BK;
    unsigned voffA[2], voffB[2];
#pragma unroll
    for (int i = 0; i < 2; ++i) { int R, C; stage_rc(tid * 16 + i * 8192, R, C); const int Rb = Epi::PERM ? ((R & ~31) + perm32(R & 31)) : R;
        voffA[i] = (unsigned)(R * K + C) * 2u; voffB[i] = (unsigned)(Rb * K + C) * 2u; }
    const size_t kstep = (size_t)(BK * 2);
    const size_t hstep = (size_t)HALF * K * 2;
    const size_t tstep = 2 * hstep;
    const unsigned ldsw = (unsigned)wid * 1024u;
    const int aoff = lds_byte(wr * 64 + fr, fq * 8), boff = lds_byte(wc * 32 + fr, fq * 8);
#define PG8_SA(b, h) (((b) * 2 + (h)) * HTB)
#define PG8_SB(b, h) ((4 + (b) * 2 + (h)) * HTB)
#define PG8_STAGE(bufoff, gbase, voff) do { _Pragma("unroll") for (int _i = 0; _i < 2; ++_i) \
        __builtin_amdgcn_global_load_lds((const unsigned*)((const char*)(gbase) + (voff)[_i]), (PG8_LAS unsigned*)(lds + (bufoff) + ldsw + _i * 8192), 16, 0, 0); } while (0)
#define PG8_LDA(dst, b, h) do { _Pragma("unroll") for (int m = 0; m < 4; ++m) _Pragma("unroll") for (int k = 0; k < 2; ++k) dst[m][k] = *(const PG8_LAS bf16x8*)(lds + PG8_SA(b, h) + aoff + m * 2048 + k * 1024); } while (0)
#define PG8_LDB(dst, b, h) do { _Pragma("unroll") for (int n = 0; n < 2; ++n) _Pragma("unroll") for (int k = 0; k < 2; ++k) dst[n][k] = *(const PG8_LAS bf16x8*)(lds + PG8_SB(b, h) + boff + n * 2048 + k * 1024); } while (0)
#define PG8_MMA(ai, bj, At, Bt) do { __builtin_amdgcn_s_setprio(1); _Pragma("unroll") for (int m = 0; m < 4; ++m) _Pragma("unroll") for (int n = 0; n < 2; ++n) _Pragma("unroll") for (int k = 0; k < 2; ++k) \
        acc[ai][bj][m][n] = __builtin_amdgcn_mfma_f32_16x16x32_bf16(Bt[n][k], At[m][k], acc[ai][bj][m][n], 0, 0, 0); __builtin_amdgcn_s_setprio(0); } while (0)
#define PG8_WAIT_V(n) asm volatile("s_waitcnt vmcnt(" #n ")" ::: "memory")
#define PG8_WAIT_L(n) asm volatile("s_waitcnt lgkmcnt(" #n ")" ::: "memory")
#define PG8_BAR __builtin_amdgcn_s_barrier()
#define PG8_SCHED __builtin_amdgcn_sched_barrier(0)
    Unit cur, nxt; int ui = 0;
    if (!S.next(0, cur)) return;
    f32x4 acc[2][2][4][2];
#pragma unroll
    for (int a = 0; a < 2; ++a)
#pragma unroll
        for (int b = 0; b < 2; ++b)
#pragma unroll
            for (int m = 0; m < 4; ++m)
#pragma unroll
                for (int n = 0; n < 2; ++n) acc[a][b][m][n] = (f32x4){0.f, 0.f, 0.f, 0.f};
    bf16x8 At[4][2], B0[2][2], B1[2][2];
    const char* cA = (const char*)g.A + (size_t)(cur.pm >> 4) * g.a_bstride + (size_t)(cur.pm & 15) * tstep; const char* cB = (const char*)g.Bt + (size_t)cur.pn * tstep;
    S.a_ready(cur);
    E.prefetch(cur, 0, wid, lane);
    if constexpr (SP2) {
        PG8_STAGE(PG8_SB(0, 0), cB, voffB); PG8_STAGE(PG8_SB(0, 1), cB + hstep, voffB); PG8_STAGE(PG8_SA(0, 0), cA, voffA); PG8_STAGE(PG8_SA(0, 1), cA + hstep, voffA);
        if (wr == 1) PG8_BAR;
        PG8_WAIT_V(2); PG8_BAR;
        PG8_STAGE(PG8_SB(1, 0), cB + kstep, voffB); PG8_STAGE(PG8_SA(1, 0), cA + kstep, voffA); PG8_STAGE(PG8_SB(1, 1), cB + hstep + kstep, voffB);
        PG8_WAIT_V(6); PG8_BAR;
    } else {
        PG8_STAGE(PG8_SB(0, 0), cB, voffB); PG8_STAGE(PG8_SA(0, 0), cA, voffA); PG8_STAGE(PG8_SB(0, 1), cB + hstep, voffB); PG8_STAGE(PG8_SA(0, 1), cA + hstep, voffA);
        if (wr == 1) PG8_BAR;
        PG8_WAIT_V(4); PG8_BAR;
        PG8_STAGE(PG8_SB(1, 0), cB + kstep, voffB); PG8_STAGE(PG8_SA(1, 0), cA + kstep, voffA); PG8_STAGE(PG8_SB(1, 1), cB + hstep + kstep, voffB);
        PG8_WAIT_V(6); PG8_BAR;
    }
    for (;;) {
        const bool has_next = S.next(ui + 1, nxt);
        const char* nA = has_next ? (const char*)g.A + (size_t)(nxt.pm >> 4) * g.a_bstride + (size_t)(nxt.pm & 15) * tstep : cA; const char* nB = has_next ? (const char*)g.Bt + (size_t)nxt.pn * tstep : cB;
        asm volatile(".p2align 8" ::: "memory");
        for (int t = 0; t < nt; t += 2) {
            const bool last = (t == nt - 2);
            const char* a1 = cA + (size_t)(t + 1) * kstep;
            const char* a2 = last ? nA : cA + (size_t)(t + 2) * kstep; const char* b2 = last ? nB : cB + (size_t)(t + 2) * kstep;
            const char* a3 = a2 + kstep; const char* b3 = b2 + kstep;
            if (last && has_next) S.a_ready(nxt);
            if constexpr (SP2) {
            PG8_LDB(B0, 0, 0); PG8_LDB(B1, 0, 1); PG8_SCHED; PG8_LDA(At, 0, 0); PG8_STAGE(PG8_SA(1, 1), a1 + hstep, voffA);
            PG8_WAIT_V(8); PG8_WAIT_L(0); PG8_BAR; PG8_MMA(0, 0, At, B0); PG8_MMA(0, 1, At, B1); PG8_BAR; PG8_SCHED;
            PG8_LDA(At, 0, 1); PG8_STAGE(PG8_SB(0, 0), b2, voffB); PG8_STAGE(PG8_SB(0, 1), b2 + hstep, voffB); PG8_STAGE(PG8_SA(0, 0), a2, voffA);
            PG8_WAIT_V(8); PG8_WAIT_L(0); PG8_BAR; PG8_MMA(1, 0, At, B0); PG8_MMA(1, 1, At, B1); PG8_BAR; PG8_SCHED;
            PG8_LDB(B0, 1, 0); PG8_LDB(B1, 1, 1); PG8_SCHED; PG8_LDA(At, 1, 0); PG8_STAGE(PG8_SA(0, 1), a2 + hstep, voffA);
            PG8_WAIT_V(8); PG8_WAIT_L(0); PG8_BAR; PG8_MMA(0, 0, At, B0); PG8_MMA(0, 1, At, B1); PG8_BAR; PG8_SCHED;
            PG8_LDA(At, 1, 1); PG8_STAGE(PG8_SB(1, 0), b3, voffB); PG8_STAGE(PG8_SB(1, 1), b3 + hstep, voffB); PG8_STAGE(PG8_SA(1, 0), a3, voffA);
            PG8_WAIT_V(8); PG8_WAIT_L(0); PG8_BAR; PG8_MMA(1, 0, At, B0); PG8_MMA(1, 1, At, B1); PG8_BAR; PG8_SCHED;
            } else {
            PG8_LDB(B0, 0, 0); PG8_SCHED; PG8_LDA(At, 0, 0); PG8_STAGE(PG8_SA(1, 1), a1 + hstep, voffA);
            PG8_WAIT_L(8); PG8_BAR; PG8_WAIT_L(0); PG8_MMA(0, 0, At, B0); PG8_BAR; PG8_SCHED;
            PG8_LDB(B1, 0, 1); PG8_STAGE(PG8_SB(0, 0), b2, voffB);
            PG8_BAR; PG8_WAIT_L(0); PG8_MMA(0, 1, At, B1); PG8_BAR;
            PG8_LDA(At, 0, 1); PG8_STAGE(PG8_SA(0, 0), a2, voffA);
            PG8_BAR; PG8_WAIT_L(0); PG8_MMA(1, 0, At, B0); PG8_BAR; PG8_SCHED;
            PG8_STAGE(PG8_SB(0, 1), b2 + hstep, voffB);
            PG8_WAIT_V(6); PG8_BAR; PG8_MMA(1, 1, At, B1); PG8_BAR;
            PG8_LDB(B0, 1, 0); PG8_SCHED; PG8_LDA(At, 1, 0); PG8_STAGE(PG8_SA(0, 1), a2 + hstep, voffA);
            PG8_WAIT_L(8); PG8_BAR; PG8_WAIT_L(0); PG8_MMA(0, 0, At, B0); PG8_BAR; PG8_SCHED;
            PG8_LDB(B1, 1, 1); PG8_STAGE(PG8_SB(1, 0), b3, voffB);
            PG8_BAR; PG8_WAIT_L(0); PG8_MMA(0, 1, At, B1); PG8_BAR;
            PG8_LDA(At, 1, 1); PG8_STAGE(PG8_SA(1, 0), a3, voffA);
            PG8_BAR; PG8_WAIT_L(0); PG8_MMA(1, 0, At, B0); PG8_BAR; PG8_SCHED;
            PG8_STAGE(PG8_SB(1, 1), b3 + hstep, voffB);
            PG8_WAIT_V(6); PG8_BAR; PG8_MMA(1, 1, At, B1); PG8_BAR;
            }
        }
        if constexpr (ALIGN_EPI) { if (wr == 0) PG8_BAR; }
        if constexpr (!Epi::AFTER_DRAIN) { E(acc, cur, wr, wc, fr, fq, ui); S.done(cur); }
        if (!has_next) break;
#pragma unroll
        for (int a = 0; a < 2; ++a)
#pragma unroll
            for (int b = 0; b < 2; ++b)
#pragma unroll
                for (int m = 0; m < 4; ++m)
#pragma unroll
                    for (int n = 0; n < 2; ++n) acc[a][b][m][n] = (f32x4){0.f, 0.f, 0.f, 0.f};
        cur = nxt; cA = nA; cB = nB; ++ui;
        E.prefetch(cur, ui, wid, lane);
        if constexpr (ALIGN_EPI) { if (wr == 1) PG8_BAR; }
    }
    PG8_WAIT_V(0);
    if constexpr (!ALIGN_EPI) { if (wr == 0) PG8_BAR; }
    PG8_BAR;
#undef PG8_SA
#undef PG8_SB
#undef PG8_STAGE
#undef PG8_LDA
#undef PG8_LDB
#undef PG8_MMA
#undef PG8_WAIT_V
#undef PG8_WAIT_L
#undef PG8_BAR
#undef PG8_SCHED
}
}

constexpr int NWAVES = 8;
constexpr int DEPTH = 4, BATCH = 8, SEQ = 4096, D = 1024, M = BATCH * SEQ, DIN = 2560, FF = 4096, NH = 8;
constexpr int LDS_BYTES = 147456;
constexpr size_t MiB = 1u << 20;
constexpr size_t WS_SS = 416 * MiB, SS_BYTES = (size_t)9 * M * 4 * 4;
constexpr size_t WS_BAR = 1536 * 1024, BAR_BYTES = 32768;
constexpr int MISC_OFF = 131072 + 320;
constexpr size_t WS_W = 2 * MiB, W_LAYER = 23 * MiB;
constexpr size_t WO_MAIN = 0, WO_V = 4 * MiB, WO_OUT = 5 * MiB, WO_1 = 7 * MiB, WO_2 = 15 * MiB;
constexpr size_t WS_XB = 96 * MiB;
constexpr size_t WS_SLAB = 160 * MiB;
constexpr size_t WS_QB = WS_SLAB, WS_KB = WS_SLAB + 4 * MiB, WS_VB = WS_SLAB + 8 * MiB, WS_R = WS_SLAB + 12 * MiB, WS_MIX = WS_SLAB + 20 * MiB;
constexpr size_t WS_H = WS_SLAB;
constexpr size_t WS_END = 440 * MiB;
static_assert(WS_W + DEPTH * W_LAYER <= WS_XB && WS_SS + SS_BYTES <= WS_END, "ws map");

#define LAS __attribute__((address_space(3)))
typedef unsigned short bf16;
typedef unsigned v4u __attribute__((ext_vector_type(4)));
typedef unsigned v2u __attribute__((ext_vector_type(2)));
typedef float f32x4 __attribute__((ext_vector_type(4)));
typedef float f32x16 __attribute__((ext_vector_type(16)));
typedef short bf16x8 __attribute__((ext_vector_type(8)));
#define LDS_WAIT() asm volatile("s_waitcnt lgkmcnt(0)" ::: "memory")

__device__ __forceinline__ unsigned pk2(float lo, float hi) { return pg8::cvt_pk_bf16(lo, hi); }
__device__ __forceinline__ float bflo(unsigned w) { return __uint_as_float(w << 16); }
__device__ __forceinline__ float bfhi(unsigned w) { return __uint_as_float(w & 0xffff0000u); }
__device__ __forceinline__ float wave_sum(float v) {
#pragma unroll
    for (int o = 1; o < 64; o <<= 1) v += __shfl_xor(v, o);
    return v;
}

struct TrItem { const float* src; const float* gk; bf16* dst; int ldw, K; };
__device__ __forceinline__ void tr_load(const TrItem& it, f32x4 (&v)[8], int lane) {
    const int kr = lane >> 3, c4 = (lane & 7) * 4;
#pragma unroll
    for (int i = 0; i < 8; ++i) v[i] = *(const f32x4*)(it.src + (size_t)(8 * i + kr) * it.ldw + c4);
}
__device__ __forceinline__ void tr_finish(const TrItem& it, f32x4 (&v)[8], LAS float* scr, int lane) {
    const int kr = lane >> 3, c4 = (lane & 7) * 4;
    if (it.gk) {
#pragma unroll
        for (int i = 0; i < 8; ++i) v[i] = v[i] * it.gk[8 * i + kr];
    }
#pragma unroll
    for (int i = 0; i < 8; ++i) { LAS float* d = scr + (8 * i + kr) * 33 + c4; d[0] = v[i][0]; d[1] = v[i][1]; d[2] = v[i][2]; d[3] = v[i][3]; }
    LDS_WAIT(); asm volatile("" ::: "memory");
    const int c = lane & 7;
#pragma unroll
    for (int j = 0; j < 4; ++j) { const int n = (lane >> 3) + 8 * j; const LAS float* s = scr + (8 * c) * 33 + n;
        v4u o; o.x = pk2(s[0 * 33], s[1 * 33]); o.y = pk2(s[2 * 33], s[3 * 33]); o.z = pk2(s[4 * 33], s[5 * 33]); o.w = pk2(s[6 * 33], s[7 * 33]);
        *(v4u*)(it.dst + (size_t)n * it.K + 8 * c) = o; }
    LDS_WAIT(); asm volatile("" ::: "memory");
}

struct Args { const float* in[13]; float* out; unsigned char* ws; };

__device__ __forceinline__ void prologue(const Args& a, LAS unsigned char* lds, int ws) {
    const int tid = pg8::opaque_tid(ws), lane = tid & 63, wave = __builtin_amdgcn_readfirstlane(tid >> 6);
    LAS float* scr = (LAS float*)(lds + wave * 16384);
    const int gw = blockIdx.x * NWAVES + wave, NGW = gridDim.x * NWAVES;
    constexpr int PER_LAYER = 5760;
    auto decode = [&](int it) -> TrItem {
        const int l = it / PER_LAYER; int r = it % PER_LAYER;
        unsigned char* wl = a.ws + WS_W + (size_t)l * W_LAYER;
        TrItem t;
        if (r < 1024) {
            const int kb = r >> 6, db = r & 63, pn = db >> 3, jb = db & 7, bj = jb >> 2, wc = jb & 3;
            const int scol = pn < 4 ? (256 * pn + 64 * wc + 32 * bj) : (1536 + 256 * (pn - 4) + 32 * jb);
            t.src = a.in[2] + (size_t)l * D * DIN + (size_t)(64 * kb) * DIN + scol; t.ldw = DIN; t.gk = a.in[1] + l * D + 64 * kb; t.dst = (bf16*)(wl + WO_MAIN) + (size_t)(32 * db) * D + 64 * kb; t.K = D; return t; }
        r -= 1024;
        if (r < 256) { const int kb = r >> 4, db = r & 15;
            t.src = a.in[2] + (size_t)l * D * DIN + (size_t)(64 * kb) * DIN + 1024 + 32 * db; t.ldw = DIN; t.gk = a.in[1] + l * D + 64 * kb; t.dst = (bf16*)(wl + WO_V) + (size_t)(32 * db) * D + 64 * kb; t.K = D; return t; }
        r -= 256;
        if (r < 384) { const int kb = r >> 5, nb = r & 31;
            t.src = a.in[9] + (size_t)l * D * D + (size_t)(64 * kb) * D + 32 * nb; t.ldw = D; t.gk = nullptr; t.dst = (bf16*)(wl + WO_OUT) + (size_t)(32 * nb) * D + 64 * kb; t.K = D; return t; }
        r -= 384;
        if (r < 2048) { const int kb = r >> 7, nb = r & 127;
            t.src = a.in[11] + (size_t)l * D * FF + (size_t)(64 * kb) * FF + 32 * nb; t.ldw = FF; t.gk = a.in[10] + l * D + 64 * kb; t.dst = (bf16*)(wl + WO_1) + (size_t)(32 * nb) * D + 64 * kb; t.K = D; return t; }
        r -= 2048;
        { const int kb = r >> 5, nb = r & 31;
            t.src = a.in[12] + (size_t)l * FF * D + (size_t)(64 * kb) * D + 32 * nb; t.ldw = D; t.gk = nullptr; t.dst = (bf16*)(wl + WO_2) + (size_t)(32 * nb) * FF + 64 * kb; t.K = FF; return t; }
    };
    if (gw < DEPTH * PER_LAYER) {
        TrItem cur = decode(gw); f32x4 v[8]; tr_load(cur, v, lane);
        for (int it = gw; it < DEPTH * PER_LAYER; it += NGW) {
            const int nx = it + NGW;
            if (nx < DEPTH * PER_LAYER) { const TrItem nxt = decode(nx); f32x4 vn[8]; tr_load(nxt, vn, lane); tr_finish(cur, v, scr, lane); cur = nxt;
#pragma unroll
                for (int i = 0; i < 8; ++i) v[i] = vn[i]; }
            else tr_finish(cur, v, scr, lane);
        }
    }
    for (int it = blockIdx.x * (NWAVES * 64) + tid; it < DEPTH * 4 * 8 * 1024; it += gridDim.x * NWAVES * 64) {
        const int n = it & 1023, cc = (it >> 10) & 7, g = (it >> 13) & 3, l = it >> 15;
        const float* wo = a.in[9] + (size_t)l * D * D + (size_t)(768 + 64 * g) * D + n;
        const float* sc = a.in[8] + l * 256 + 64 * g;
        const float* pw = a.in[7] + ((size_t)(l * 4 + g) * 64 + 8 * cc) * 64;
        float acc[8];
#pragma unroll
        for (int j = 0; j < 8; ++j) acc[j] = 0.f;
        for (int d0 = 0; d0 < 64; d0 += 16) {
            float wv[16];
#pragma unroll
            for (int i = 0; i < 16; ++i) wv[i] = wo[(size_t)(d0 + i) * D];
#pragma unroll
            for (int i = 0; i < 16; ++i) { const float x = wv[i] * sc[d0 + i];
#pragma unroll
                for (int j = 0; j < 8; ++j) acc[j] += pw[j * 64 + d0 + i] * x; }
        }
        v4u o; o.x = pk2(acc[0], acc[1]); o.y = pk2(acc[2], acc[3]); o.z = pk2(acc[4], acc[5]); o.w = pk2(acc[6], acc[7]);
        *(v4u*)((bf16*)(a.ws + WS_W + (size_t)l * W_LAYER + WO_OUT) + (size_t)n * D + 768 + 64 * g + 8 * cc) = o;
    }
    bf16* XB = (bf16*)(a.ws + WS_XB); float* ss0 = (float*)(a.ws + WS_SS);
    {
        f32x4 v[4], w[4];
        { const f32x4* xr = (const f32x4*)(a.in[0] + (size_t)gw * D) + lane; const f32x4* xr2 = (const f32x4*)(a.in[0] + (size_t)(gw + NGW) * D) + lane;
#pragma unroll
          for (int j = 0; j < 4; ++j) { v[j] = xr[64 * j]; w[j] = xr2[64 * j]; } }
        for (int m = gw; m < M; m += 2 * NGW) {
            const int m2 = m + NGW, mn = m + 2 * NGW;
            f32x4 vn[4], wn[4];
            if (mn < M) { const f32x4* xr = (const f32x4*)(a.in[0] + (size_t)mn * D) + lane; const f32x4* xr2 = (const f32x4*)(a.in[0] + (size_t)(mn + NGW) * D) + lane;
#pragma unroll
                for (int j = 0; j < 4; ++j) { vn[j] = xr[64 * j]; wn[j] = xr2[64 * j]; } }
            float s = 0.f, s2 = 0.f;
            unsigned long long* o8 = (unsigned long long*)(XB + (size_t)m * D) + lane; unsigned long long* o82 = (unsigned long long*)(XB + (size_t)m2 * D) + lane;
#pragma unroll
            for (int j = 0; j < 4; ++j) { s += pg8::dot4(v[j]); o8[64 * j] = (unsigned long long)pk2(v[j][0], v[j][1]) | ((unsigned long long)pk2(v[j][2], v[j][3]) << 32);
                                          s2 += pg8::dot4(w[j]); o82[64 * j] = (unsigned long long)pk2(w[j][0], w[j][1]) | ((unsigned long long)pk2(w[j][2], w[j][3]) << 32); }
            s = wave_sum(s); s2 = wave_sum(s2);
            if (lane < 4) { ss0[(size_t)m * 4 + lane] = lane == 0 ? s : 0.f; ss0[(size_t)m2 * 4 + lane] = lane == 0 ? s2 : 0.f; }
            if (mn < M) {
#pragma unroll
                for (int j = 0; j < 4; ++j) { v[j] = vn[j]; w[j] = wn[j]; } }
        }
    }
}

struct Mode { int local, rank, xcc; };
__device__ __forceinline__ float max3f(float a, float b, float c) { return fmaxf(fmaxf(a, b), c); }
__device__ __forceinline__ float fadd_s(float a, float b) { float r; asm("v_add_f32_e32 %0, %1, %2" : "=v"(r) : "v"(a), "v"(b)); return r; }
__device__ __forceinline__ float swap32_max(float m) { auto rr = __builtin_amdgcn_permlane32_swap(__float_as_uint(m), __float_as_uint(m), false, false); return fmaxf(__uint_as_float(rr[0]), __uint_as_float(rr[1])); }
__device__ __forceinline__ float swap32_sum(float m) { auto rr = __builtin_amdgcn_permlane32_swap(__float_as_uint(m), __float_as_uint(m), false, false); return __uint_as_float(rr[0]) + __uint_as_float(rr[1]); }
typedef float f32x2_t __attribute__((ext_vector_type(2))); typedef __bf16 bf16x2_t __attribute__((ext_vector_type(2)));
__device__ __forceinline__ unsigned cvtpk_s(float lo, float hi) { f32x2_t v = {lo, hi}; bf16x2_t b = __builtin_convertvector(v, bf16x2_t); return __builtin_bit_cast(unsigned, b); }

__device__ __forceinline__ void attn_load_k(bf16x8 (&kf)[2][4], const bf16* kb, int lane) {
#pragma unroll
    for (int hf = 0; hf < 2; ++hf)
#pragma unroll
        for (int d0 = 0; d0 < 4; ++d0) kf[hf][d0] = *(const bf16x8*)(kb + d0 * 1024 + hf * 512 + lane * 8);
}
__device__ __forceinline__ void attn_load_v(bf16x8 (&vf)[2][4], const bf16* vb, int lane) {
#pragma unroll
    for (int dh = 0; dh < 2; ++dh)
#pragma unroll
        for (int s = 0; s < 4; ++s) vf[dh][s] = *(const bf16x8*)(vb + s * 1024 + dh * 512 + lane * 8);
}
__device__ __forceinline__ void attn_qk(const bf16x8 (&kf)[2][4], const bf16x8 (&qr)[4], f32x16& p0, f32x16& p1) {
    p0 = f32x16{}; p1 = f32x16{};
#pragma unroll
    for (int d0 = 0; d0 < 4; ++d0) { p0 = __builtin_amdgcn_mfma_f32_32x32x16_bf16(kf[0][d0], qr[d0], p0, 0, 0, 0); p1 = __builtin_amdgcn_mfma_f32_32x32x16_bf16(kf[1][d0], qr[d0], p1, 0, 0, 0); }
}
__device__ __forceinline__ void attn_softmax_pv(f32x16& p0, f32x16& p1, const bf16x8 (&vf)[2][4], int j, int qi, int hi, const LAS float* tb, float cb,
                                                float& mrun, float& l, f32x16& o0, f32x16& o1) {
    const float c0 = (j <= 5) ? cb : 0.f;
    if (j >= 6) {
        const LAS float* tq = tb + (qi + 64 * (8 - j) + 128 - 8 * hi - 55);
#pragma unroll
        for (int r = 0; r < 16; ++r) { const int key = (r >> 3) * 16 + (r & 7); p0[r] = fadd_s(p0[r], tq[55 - key]); p1[r] = fadd_s(p1[r], tq[55 - key - 32]); }
    }
    float rm = max3f(p0[0], p0[1], p1[0]);
#pragma unroll
    for (int r = 1; r < 16; ++r) rm = max3f(rm, p0[r], p1[r]);
    rm = fmaxf(rm, p0[0]); rm = swap32_max(rm);
    const float cand = rm + c0; const bool grow = cand > mrun + 8.f;
    const float mnew = grow ? cand : mrun, alpha = __builtin_amdgcn_exp2f(mrun - mnew); mrun = mnew;
    const float sub = mnew - c0;
    float rs0 = 0.f, rs1 = 0.f, rs2 = 0.f, rs3 = 0.f;
#pragma unroll
    for (int r = 0; r < 16; ++r) { p0[r] = __builtin_amdgcn_exp2f(p0[r] - sub); p1[r] = __builtin_amdgcn_exp2f(p1[r] - sub); }
#pragma unroll
    for (int r = 0; r < 16; r += 2) { rs0 = fadd_s(rs0, p0[r]); rs1 = fadd_s(rs1, p1[r]); rs2 = fadd_s(rs2, p0[r + 1]); rs3 = fadd_s(rs3, p1[r + 1]); }
    const float rsum = fadd_s(fadd_s(rs0, rs1), fadd_s(rs2, rs3));
    l = l * alpha + rsum;
    if (__builtin_amdgcn_ballot_w64(grow) != 0ull) {
#pragma unroll
        for (int r = 0; r < 16; ++r) { o0[r] *= alpha; o1[r] *= alpha; }
    }
    v4u pw[4];
#pragma unroll
    for (int s = 0; s < 2; ++s) {
        pw[s] = (v4u){cvtpk_s(p0[8 * s + 0], p0[8 * s + 1]), cvtpk_s(p0[8 * s + 2], p0[8 * s + 3]), cvtpk_s(p0[8 * s + 4], p0[8 * s + 5]), cvtpk_s(p0[8 * s + 6], p0[8 * s + 7])};
        pw[2 + s] = (v4u){cvtpk_s(p1[8 * s + 0], p1[8 * s + 1]), cvtpk_s(p1[8 * s + 2], p1[8 * s + 3]), cvtpk_s(p1[8 * s + 4], p1[8 * s + 5]), cvtpk_s(p1[8 * s + 6], p1[8 * s + 7])};
    }
#pragma unroll
    for (int s = 0; s < 4; ++s) { const bf16x8 pf = __builtin_bit_cast(bf16x8, pw[s]);
        o0 = __builtin_amdgcn_mfma_f32_32x32x16_bf16(vf[0][s], pf, o0, 0, 0, 0); o1 = __builtin_amdgcn_mfma_f32_32x32x16_bf16(vf[1][s], pf, o1, 0, 0, 0); }
}
__device__ __forceinline__ void attn_wave_unit64(int b, int h, int n, const bf16* QB, const bf16* KB, const bf16* VB, bf16* MIX, const LAS float* tab, LAS unsigned char* qslot, int lane_) {
    int lane = lane_; asm volatile("" : "+v"(lane));
    const int r32 = lane & 31, hi = lane >> 5;
    const size_t tok0 = (size_t)b * pg8::SLAB_E / 512 + n * 64 + r32;
#pragma unroll
    for (int hf = 0; hf < 2; ++hf)
#pragma unroll
        for (int d0 = 0; d0 < 4; ++d0) *(LAS bf16x8*)(qslot + (hf * 4 + d0) * 1024 + lane * 16) = *(const bf16x8*)(QB + (tok0 + hf * 32) * 512 + h * 64 + d0 * 16 + hi * 8);
    float mrunA = -1e30f, lA = 0.f, mrunB = -1e30f, lB = 0.f; f32x16 oA0 = f32x16{}, oA1 = f32x16{}, oB0 = f32x16{}, oB1 = f32x16{};
    const LAS float* tb = tab + h * 320;
    const float cb = tb[256];
    int j = (n < 8 ? 8 - n : 0);
    const bf16* kb = KB + (size_t)b * pg8::SLAB_E + (size_t)(h * 64 + (n + j - 8)) * 4096; const bf16* vb = VB + (size_t)b * pg8::SLAB_E + (size_t)(h * 64 + (n + j - 8)) * 4096;
    bf16x8 kf[2][4], vf[2][4]; f32x16 p0, p1; bf16x8 qr[4];
    attn_load_k(kf, kb, lane); attn_load_v(vf, vb, lane);
    for (;;) {
#pragma unroll
        for (int d0 = 0; d0 < 4; ++d0) qr[d0] = *(const LAS bf16x8*)(qslot + d0 * 1024 + lane * 16);
        attn_qk(kf, qr, p0, p1);
        attn_softmax_pv(p0, p1, vf, j, r32, hi, tb, cb, mrunA, lA, oA0, oA1);
#pragma unroll
        for (int d0 = 0; d0 < 4; ++d0) qr[d0] = *(const LAS bf16x8*)(qslot + (4 + d0) * 1024 + lane * 16);
        attn_qk(kf, qr, p0, p1);
        kb += 4096;
        if (j < 8) attn_load_k(kf, kb, lane);
        attn_softmax_pv(p0, p1, vf, j, 32 + r32, hi, tb, cb, mrunB, lB, oB0, oB1);
        if (j == 8) break;
        vb += 4096; attn_load_v(vf, vb, lane);
        ++j;
    }
    const float linvA = 1.f / swap32_sum(lA), linvB = 1.f / swap32_sum(lB);
    int lane2 = lane; asm volatile("" : "+v"(lane2));
    bf16* orow = MIX + (size_t)b * pg8::SLAB_E + (size_t)(n * 64 + (lane2 & 31)) * 1024 + h * 64 + 4 * (lane2 >> 5);
#pragma unroll
    for (int r4 = 0; r4 < 4; ++r4) {
        v2u w0, w1;
        w0.x = cvtpk_s(oA0[4 * r4] * linvA, oA0[4 * r4 + 1] * linvA); w0.y = cvtpk_s(oA0[4 * r4 + 2] * linvA, oA0[4 * r4 + 3] * linvA);
        w1.x = cvtpk_s(oA1[4 * r4] * linvA, oA1[4 * r4 + 1] * linvA); w1.y = cvtpk_s(oA1[4 * r4 + 2] * linvA, oA1[4 * r4 + 3] * linvA);
        *(v2u*)(orow + 8 * r4) = w0; *(v2u*)(orow + 32 + 8 * r4) = w1;
        w0.x = cvtpk_s(oB0[4 * r4] * linvB, oB0[4 * r4 + 1] * linvB); w0.y = cvtpk_s(oB0[4 * r4 + 2] * linvB, oB0[4 * r4 + 3] * linvB);
        w1.x = cvtpk_s(oB1[4 * r4] * linvB, oB1[4 * r4 + 1] * linvB); w1.y = cvtpk_s(oB1[4 * r4 + 2] * linvB, oB1[4 * r4 + 3] * linvB);
        *(v2u*)(orow + 32 * 1024 + 8 * r4) = w0; *(v2u*)(orow + 32 * 1024 + 32 + 8 * r4) = w1;
    }
}

__device__ __forceinline__ void unpack8(const v4u w, float (&f)[8]) { f[0] = bflo(w.x); f[1] = bfhi(w.x); f[2] = bflo(w.y); f[3] = bfhi(w.y); f[4] = bflo(w.z); f[5] = bfhi(w.z); f[6] = bflo(w.w); f[7] = bfhi(w.w); }

__device__ __forceinline__ void mixer_phase(const Args& a, int l, LAS unsigned char* lds, int ws, const Mode md) {
    const int tid = pg8::opaque_tid(ws), lane = tid & 63, wave = __builtin_amdgcn_readfirstlane(tid >> 6);
    const bf16* QB = (const bf16*)(a.ws + WS_QB); const bf16* KB = (const bf16*)(a.ws + WS_KB); const bf16* VB = (const bf16*)(a.ws + WS_VB);
    const bf16* Rall = (const bf16*)(a.ws + WS_R); bf16* MIXall = (bf16*)(a.ws + WS_MIX); bf16* MIX = MIXall;
    LAS float* tab = (LAS float*)lds;
    { const float* rb = a.in[5] + (size_t)l * NH * 257;
      for (int i = tid; i < NH * 320; i += NWAVES * 64) { const int h = i / 320, e = i % 320; tab[i] = rb[h * 257 + (e < 256 ? e : 256)] * 1.4426950408889634f; } }
    __syncthreads();
    const int gw = blockIdx.x * NWAVES + wave, NGW = gridDim.x * NWAVES;
    for (int stage = 0; stage < 2; ++stage) {
      if ((stage == 0) == (wave < 4)) {
        for (int k = 0; ; ++k) {
            const int blk = blockIdx.x;
            int bu;
            if (md.local) bu = k < 2 ? md.xcc * 64 + k * 32 + md.rank : 512;
            else if (gridDim.x == 256) { const int x = blk & 7, i = blk >> 3; bu = k < 2 ? ((k * 8 + x) * 4 + (i >> 3)) * 8 + (i & 7) : 512; }
            else bu = k * (int)gridDim.x + blk;
            if (bu >= BATCH * NH * 8) break;
            const int bh = bu >> 3, ng = bu & 7;
            attn_wave_unit64(bh >> 3, bh & 7, ng * 8 + wave, QB, KB, VB, MIX, tab, lds + 16384 + wave * 8192, lane);
        }
      } else {
        int tid2 = tid; asm volatile("" : "+v"(tid2));
        const int gt = md.local ? md.rank * (NWAVES * 64) + tid2 : blockIdx.x * (NWAVES * 64) + tid2, NGT = md.local ? 131072 : gridDim.x * NWAVES * 64;
        for (int it0 = gt; it0 < 131072; it0 += NGT) {
            const int it = md.local ? ((it0 >> 13) << 16) + ((md.xcc * 256 + ((it0 >> 5) & 255)) << 5) + (it0 & 31) : it0;
            const int type = it >> 16, vec = it & 31, run = (it & 65535) >> 5;
            const size_t tokg = (size_t)run * 16; const int tpos0 = (int)(tokg & (SEQ - 1)); const int c = vec * 8;
            const size_t tok0 = tpos0;
            const bf16* R = Rall + (tokg >> 12) * pg8::SLAB_E; bf16* MIX = MIXall + (tokg >> 12) * pg8::SLAB_E;
            if (type == 0) {
                const float* cw = a.in[6] + (size_t)l * 3 * 256 + c;
                float w0[8], w1[8], w2[8], zp2[8], zp1[8];
                { const f32x4 x0 = *(const f32x4*)(cw), x1 = *(const f32x4*)(cw + 4), y0 = *(const f32x4*)(cw + 256), y1 = *(const f32x4*)(cw + 260), z0 = *(const f32x4*)(cw + 512), z1 = *(const f32x4*)(cw + 516);
    #pragma unroll
                  for (int e = 0; e < 4; ++e) { w0[e] = x0[e]; w0[4 + e] = x1[e]; w1[e] = y0[e]; w1[4 + e] = y1[e]; w2[e] = z0[e]; w2[4 + e] = z1[e]; } }
                if (tpos0 >= 2) {
                    float g1[8], h1[8], g2[8], h2[8];
                    unpack8(*(const v4u*)(R + (tok0 - 2) * 1024 + 256 + c), g2); unpack8(*(const v4u*)(R + (tok0 - 2) * 1024 + 512 + c), h2);
                    unpack8(*(const v4u*)(R + (tok0 - 1) * 1024 + 256 + c), g1); unpack8(*(const v4u*)(R + (tok0 - 1) * 1024 + 512 + c), h1);
    #pragma unroll
                    for (int e = 0; e < 8; ++e) { zp2[e] = g2[e] * h2[e]; zp1[e] = g1[e] * h1[e]; }
                } else {
    #pragma unroll
                    for (int e = 0; e < 8; ++e) { zp2[e] = 0.f; zp1[e] = 0.f; }
                }
                for (int t4 = 0; t4 < 16; t4 += 4) {
                    v4u rgb[4], rgc[4], rhn[4];
    #pragma unroll
                    for (int t = 0; t < 4; ++t) { const bf16* rr = R + (tok0 + t4 + t) * 1024 + c; rgb[t] = *(const v4u*)(rr); rgc[t] = *(const v4u*)(rr + 256); rhn[t] = *(const v4u*)(rr + 512); }
    #pragma unroll
                    for (int t = 0; t < 4; ++t) {
                        float gb[8], gc[8], hn[8], y[8];
                        unpack8(rgb[t], gb); unpack8(rgc[t], gc); unpack8(rhn[t], hn);
    #pragma unroll
                        for (int e = 0; e < 8; ++e) { const float z = gc[e] * hn[e]; y[e] = gb[e] * (w0[e] * zp2[e] + w1[e] * zp1[e] + w2[e] * z); zp2[e] = zp1[e]; zp1[e] = z; }
                        v4u o; o.x = pk2(y[0], y[1]); o.y = pk2(y[2], y[3]); o.z = pk2(y[4], y[5]); o.w = pk2(y[6], y[7]);
                        *(v4u*)(MIX + (tok0 + t4 + t) * 1024 + 512 + c) = o;
                    }
                }
            } else {
                const int w = 2 << (vec >> 3);
                const bf16* ub = R + 768 + c;
                float S[8];
    #pragma unroll
                for (int e = 0; e < 8; ++e) S[e] = 0.f;
                if (tpos0 > 0) {
                    for (int j = 1; j < w; ++j) { float uu[8]; unpack8(*(const v4u*)(ub + (tok0 - j) * 1024), uu);
    #pragma unroll
                        for (int e = 0; e < 8; ++e) S[e] += uu[e]; }
                }
                for (int t4 = 0; t4 < 16; t4 += 4) {
                    v4u ru[4], ro[4];
    #pragma unroll
                    for (int t = 0; t < 4; ++t) { ru[t] = *(const v4u*)(ub + (tok0 + t4 + t) * 1024);
                        const int tpo = tpos0 + t4 + t - (w - 1);
                        ro[t] = *(const v4u*)(ub + (tok0 + t4 + t - (tpo >= 0 ? (w - 1) : 0)) * 1024); }
    #pragma unroll
                    for (int t = 0; t < 4; ++t) {
                        float ut[8], uo[8], mm[8]; unpack8(ru[t], ut); unpack8(ro[t], uo);
                        const int tp = tpos0 + t4 + t; const float rc = 1.f / (float)(tp + 1 < w ? tp + 1 : w);
                        const bool drop = tp - (w - 1) >= 0;
    #pragma unroll
                        for (int e = 0; e < 8; ++e) { S[e] += ut[e]; mm[e] = S[e] * rc - ut[e]; S[e] -= drop ? uo[e] : 0.f; }
                        v4u o; o.x = pk2(mm[0], mm[1]); o.y = pk2(mm[2], mm[3]); o.z = pk2(mm[4], mm[5]); o.w = pk2(mm[6], mm[7]);
                        *(v4u*)(MIX + (tok0 + t4 + t) * 1024 + 768 + c) = o;
                    }
                }
            }
        }
      }
    }
    __syncthreads();
}

#define XB_TMO      128
#define XB_XCNT(j)  (256  + 64 * (j))
#define XB_XSUB(j)  (1280 + 64 * (j))
#define XB_XGEN(j)  (2304 + 64 * (j))
#define XB_TOP      3328
#define XB_TOPGEN   3392
#define XCD_BAR_WORDS 3456
#define XB_SPIN_CAP (1u << 22)
__device__ __forceinline__ unsigned xb_ld(unsigned* p)              { return __hip_atomic_load(p, __ATOMIC_RELAXED, __HIP_MEMORY_SCOPE_AGENT); }
__device__ __forceinline__ unsigned xb_add(unsigned* p, unsigned v) { return __hip_atomic_fetch_add(p, v, __ATOMIC_RELAXED, __HIP_MEMORY_SCOPE_AGENT); }
__device__ __forceinline__ unsigned xb_xcc_id() { return (unsigned)__builtin_amdgcn_s_getreg((3 << 11) | 20) & 0xFu; }
#define XB_SPIN(cond, bar) do { unsigned _sp = 0; while (cond) { __builtin_amdgcn_s_sleep(1); \
    if ((++_sp & 255u) == 0u) { if (xb_ld(&(bar)[XB_TMO])) break; if (_sp > XB_SPIN_CAP) { atomicAdd(&(bar)[XB_TMO], 1u); break; } } } } while (0)
struct XcdBarrier { unsigned* bar; unsigned x; volatile LAS unsigned* st; };
__device__ __forceinline__ XcdBarrier xcd_barrier_post(unsigned* bar, volatile LAS unsigned* st) {
    XcdBarrier b; b.bar = bar; b.x = xb_xcc_id(); b.st = st;
    if (threadIdx.x == 0) st[4] = xb_add(&bar[XB_XCNT(b.x)], 1u);
    return b;
}
__device__ __forceinline__ void xcd_barrier_complete(unsigned* bar, unsigned x, unsigned& nloc, unsigned& nx) {
    const unsigned G = gridDim.x * gridDim.y * gridDim.z;
    unsigned sum, cnt, mine, sp = 0u;
    for (;;) {
        sum = 0u; cnt = 0u; mine = 0u;
#pragma unroll
        for (unsigned j = 0; j < 16; ++j) { const unsigned c = xb_ld(&bar[XB_XCNT(j)]); sum += c; cnt += (c > 0u) ? 1u : 0u; mine = (j == x) ? c : mine; }
        if (sum == G) break;
        __builtin_amdgcn_s_sleep(1);
        if ((++sp & 255u) == 0u) { if (xb_ld(&bar[XB_TMO])) break; if (sp > XB_SPIN_CAP) { atomicAdd(&bar[XB_TMO], 1u); break; } }
    }
    nloc = mine > 0u ? mine : 1u; nx = cnt > 0u ? cnt : 1u;
}
__device__ __forceinline__ void xcd_barrier(const XcdBarrier& b, int ws) {
    asm volatile("s_waitcnt vmcnt(0)" ::: "memory");
    __syncthreads();
    if (ws == 0 && pg8::lane_id() == 0) {
        unsigned* bar = b.bar;
        __builtin_amdgcn_s_waitcnt(0);
        unsigned nloc = b.st[0], nx = b.st[1];
        if (nloc == 0u) { xcd_barrier_complete(bar, b.x, nloc, nx); b.st[0] = nloc; b.st[1] = nx; }
        const unsigned old = xb_add(&bar[XB_XSUB(b.x)], 1u);
        const unsigned gen = old / nloc;
        if (old + 1u == (gen + 1u) * nloc) {
            __builtin_amdgcn_fence(__ATOMIC_RELEASE, "agent");
            asm volatile("s_waitcnt vmcnt(0)" ::: "memory");
            const unsigned og = xb_add(&bar[XB_TOP], 1u);
            const unsigned tg = og / nx;
            if (og + 1u == (tg + 1u) * nx) xb_add(&bar[XB_TOPGEN], 1u);
            else XB_SPIN(xb_ld(&bar[XB_TOPGEN]) == tg, bar);
            __builtin_amdgcn_fence(__ATOMIC_ACQUIRE, "agent");
            xb_add(&bar[XB_XGEN(b.x)], 1u);
            asm volatile("s_waitcnt vmcnt(0)" ::: "memory");
        } else {
            XB_SPIN(xb_ld(&bar[XB_XGEN(b.x)]) == gen, bar);
            __builtin_amdgcn_fence(__ATOMIC_ACQUIRE, "agent");
            asm volatile("s_waitcnt vmcnt(0)" ::: "memory");
        }
    }
    __syncthreads();
}
#define XB_LSUB(j)  (3456 + 64 * (j))
#define XB_LGEN(j)  (4480 + 64 * (j))
__device__ __forceinline__ void xcd_local_barrier(unsigned* bar, unsigned x, int ws) {
    asm volatile("s_waitcnt vmcnt(0)" ::: "memory");
    __syncthreads();
    if (ws == 0 && pg8::lane_id() == 0) {
        const unsigned old = xb_add(&bar[XB_LSUB(x)], 1u);
        const unsigned gen = old / 32u;
        if (old + 1u == (gen + 1u) * 32u) xb_add(&bar[XB_LGEN(x)], 1u);
        else XB_SPIN(xb_ld(&bar[XB_LGEN(x)]) == gen, bar);
        __builtin_amdgcn_fence(__ATOMIC_ACQUIRE, "agent");
        asm volatile("s_waitcnt vmcnt(0)" ::: "memory");
    }
    __syncthreads();
}
__device__ __forceinline__ Mode get_mode(LAS unsigned char* lds) {
    volatile LAS unsigned* MI = (volatile LAS unsigned*)(lds + MISC_OFF);
    Mode m; m.local = __builtin_amdgcn_readfirstlane((int)MI[13]); m.rank = __builtin_amdgcn_readfirstlane((int)MI[12]); m.xcc = (int)xb_xcc_id(); return m;
}
#define gsync(grid) do { const Mode m_ = get_mode(lds); if (m_.local) xcd_local_barrier((unsigned*)(a.ws + WS_BAR), (unsigned)m_.xcc, ws); \
    else { XcdBarrier b_; b_.bar = (unsigned*)(a.ws + WS_BAR); b_.x = xb_xcc_id(); b_.st = (volatile LAS unsigned*)(lds + MISC_OFF) + 8; xcd_barrier(b_, ws); } } while (0)
__global__ void __launch_bounds__(NWAVES * 64, 2) fwd_megakernel(Args a) {
    extern __shared__ __attribute__((aligned(16))) unsigned char lds_raw[];
    LAS unsigned char* lds = (LAS unsigned char*)lds_raw;
    cg::grid_group grid = cg::this_grid();
    int ws = __builtin_amdgcn_readfirstlane(threadIdx.x >> 6); asm volatile("" : "+s"(ws));
    const int G = gridDim.x;
    unsigned char* wsp = a.ws;

    volatile LAS unsigned* MISC = (volatile LAS unsigned*)(lds + MISC_OFF);
    if (threadIdx.x < 32) MISC[threadIdx.x] = 0u;
    __syncthreads();
    (void)xcd_barrier_post((unsigned*)(wsp + WS_BAR), MISC + 8);
    if (a.ws == nullptr) grid.sync();
    prologue(a, lds, ws);
    gsync(grid);
    if (threadIdx.x == 0) {
        unsigned* bar = (unsigned*)(wsp + WS_BAR); unsigned ok = gridDim.x == 256 ? 1u : 0u;
        for (unsigned j = 0; j < 16; ++j) { const unsigned c = xb_ld(&bar[XB_XCNT(j)]); ok &= (j < 8 ? c == 32u : c == 0u) ? 1u : 0u; }
        MISC[13] = ok;
    }
    __syncthreads();

    for (int l = 0; l < DEPTH; ++l) {
        unsigned char* wsl = a.ws; asm volatile("" : "+s"(wsl));
        float* ss = (float*)(wsl + WS_SS);
        bf16* XB = (bf16*)(wsl + WS_XB); bf16* QB = (bf16*)(wsl + WS_QB); bf16* KB = (bf16*)(wsl + WS_KB); bf16* VB = (bf16*)(wsl + WS_VB);
        bf16* R = (bf16*)(wsl + WS_R); bf16* MIX = (bf16*)(wsl + WS_MIX); bf16* HB = (bf16*)(wsl + WS_H);
        unsigned char* wl = wsl + WS_W + (size_t)l * W_LAYER;
        const float* ss1 = ss + (size_t)(2 * l) * M * 4; float* ss2 = ss + (size_t)(2 * l + 1) * M * 4; float* ss3 = ss + (size_t)(2 * l + 2) * M * 4;
        {
            pg8::Gemm g{XB, (const bf16*)(wl + WO_MAIN), M, 2048, D, (size_t)SEQ * D * 2}; const Mode md = get_mode(lds); pg8::StaticOrder S; S.init(md.local ? 16 : 128, 8, md.local ? 32 : G, md.local ? md.rank : (int)blockIdx.x, !md.local, md.local ? 16 * md.xcc : 0, 0);
            PG8_LAS unsigned char* lr = lds + 131072 + 1024 + 4096;
            { const int t = pg8::opaque_tid(ws); if (t < 128) ((PG8_LAS float*)(lr + 8192))[t] = (t < 64 ? a.in[3] + l * 64 : a.in[4] + l * 64 - 64)[t]; }
            __syncthreads();
            pg8::EpiIn E{ss1, QB, KB, R, lr};
            pg8::gemm_phase<pg8::EpiIn, pg8::StaticOrder, true, true>(lds, g, S, E, ws);
            pg8::Gemm g2{(const bf16*)(wl + WO_V), XB, 512, M, D, 0}; pg8::StaticOrder S2; S2.init(2, md.local ? 16 : 128, md.local ? 32 : G, md.local ? md.rank : (int)blockIdx.x, !md.local, 0, md.local ? 16 * md.xcc : 0);
            pg8::EpiVT E2{ss1, VB, lr};
            pg8::gemm_phase<pg8::EpiVT, pg8::StaticOrder, true, true>(lds, g2, S2, E2, ws);
        }
        gsync(grid);
        mixer_phase(a, l, lds, ws, get_mode(lds));
        gsync(grid);
        {
            pg8::Gemm g{MIX, (const bf16*)(wl + WO_OUT), M, D, D, pg8::SLAB_E * 2}; const Mode md = get_mode(lds); pg8::StaticOrder S; S.init(md.local ? 16 : 128, 4, md.local ? 32 : G, md.local ? md.rank : (int)blockIdx.x, !md.local, md.local ? 16 * md.xcc : 0, 0);
            pg8::EpiRes E{XB, nullptr, XB, ss2, (PG8_LAS float*)(lds + 131072 + 1024), nullptr};
            pg8::gemm_phase<pg8::EpiRes, pg8::StaticOrder, true, true>(lds, g, S, E, ws);
        }
        gsync(grid);
        {
            pg8::Gemm g{XB, (const bf16*)(wl + WO_1), M, FF, D, (size_t)SEQ * D * 2}; const Mode md = get_mode(lds); pg8::StaticOrder S; S.init(md.local ? 16 : 128, 16, md.local ? 32 : G, md.local ? md.rank : (int)blockIdx.x, !md.local, md.local ? 16 * md.xcc : 0, 0);
            pg8::EpiRelu2 E{HB};
            pg8::gemm_phase<pg8::EpiRelu2, pg8::StaticOrder, true, true>(lds, g, S, E, ws);
        }
        gsync(grid);
        {
            pg8::Gemm g{HB, (const bf16*)(wl + WO_2), M, D, FF, pg8::SLAB_E * 2}; const Mode md = get_mode(lds); pg8::StaticOrder S; S.init(md.local ? 16 : 128, 4, md.local ? 32 : G, md.local ? md.rank : (int)blockIdx.x, !md.local, md.local ? 16 * md.xcc : 0, 0);
            pg8::EpiRes E{XB, l + 1 < DEPTH ? nullptr : a.out, l + 1 < DEPTH ? XB : nullptr, ss3, (PG8_LAS float*)(lds + 131072 + 1024), ss2};
            pg8::gemm_phase<pg8::EpiRes, pg8::StaticOrder, true, true>(lds, g, S, E, ws);
        }
        if (l + 1 < DEPTH) gsync(grid);
    }
}

extern "C" void kernel_launch(void* const* d_in, const int* in_sizes, int n_in, void* d_out, int out_size, void* d_ws, size_t ws_size, hipStream_t stream) {
    static int grid = 0;
    if (grid == 0) {
        if (n_in != 13 || in_sizes[0] != M * D || out_size != M * D || ws_size < WS_END) { fprintf(stderr, "kernel_launch: unexpected shapes (n_in %d, in0 %d, out %d, ws %zu)\n", n_in, n_in > 0 ? in_sizes[0] : -1, out_size, ws_size); grid = -1; return; }
        int dev = 0, cus = 0, per_cu = 0;
        (void)hipGetDevice(&dev); (void)hipDeviceGetAttribute(&cus, hipDeviceAttributeMultiprocessorCount, dev);
        if (hipFuncSetAttribute((const void*)fwd_megakernel, hipFuncAttributeMaxDynamicSharedMemorySize, LDS_BYTES) != hipSuccess) { fprintf(stderr, "kernel_launch: hipFuncSetAttribute failed\n"); grid = -1; return; }
        if (hipOccupancyMaxActiveBlocksPerMultiprocessor(&per_cu, (const void*)fwd_megakernel, NWAVES * 64, LDS_BYTES) != hipSuccess || per_cu < 1) { fprintf(stderr, "kernel_launch: occupancy query says %d\n", per_cu); per_cu = 1; }
        (void)hipGetLastError();
        grid = cus;
    }
    if (grid < 0) return;
    (void)hipMemsetAsync((char*)d_ws + WS_BAR, 0, BAR_BYTES, stream);
    Args a{};
    for (int i = 0; i < 13; ++i) a.in[i] = (const float*)d_in[i];
    a.out = (float*)d_out; a.ws = (unsigned char*)d_ws;
    void* args[] = {&a};
    hipError_t e = hipLaunchCooperativeKernel((const void*)fwd_megakernel, dim3(grid), dim3(NWAVES * 64), args, LDS_BYTES, stream);
    if (e != hipSuccess) fprintf(stderr, "cooperative launch failed: %s (grid %d)\n", hipGetErrorString(e), grid);
}
```
